# Optimizing an MI355X kernel written in HIP

```python
import math
import jax, jax.numpy as jnp
from jax import lax
import numpy as np

D_MODEL = 1024
BATCH = 32
SEQ = 2048
DEPTH = 4

HEAD_DIM = 64
MLA_HEADS = 8
MLA_NOPE = 64
MLA_ROPE = 32
MLA_V = 64
MLA_Q_LORA = 384
MLA_KV_LORA = 256
ROPE_THETA = 10000.0
SWA_HEADS = 8
SWA_KV_HEADS = 2
SWA_WINDOW = 128
REL_BUCKETS = 32
REL_MAX_DIST = 128
FOX_HEADS = 16
D_FF = 4 * D_MODEL
D_PLE = 256
BLOCK_Q = 128
DN_ALPHA = (2 * DEPTH) ** 0.25
DN_BETA = (8 * DEPTH) ** -0.25
NORM_EPS = 1e-5
NEG_INF = -1e30
N_EVEN = (DEPTH + 1) // 2
N_ODD = DEPTH // 2
EVEN_SPLIT = (MLA_Q_LORA, MLA_KV_LORA, MLA_ROPE, SWA_HEADS * HEAD_DIM,
              SWA_KV_HEADS * HEAD_DIM, SWA_KV_HEADS * HEAD_DIM)
EVEN_IN = MLA_Q_LORA + MLA_KV_LORA + MLA_ROPE + (SWA_HEADS + 2 * SWA_KV_HEADS) * HEAD_DIM
EVEN_MIX = MLA_HEADS * MLA_V + SWA_HEADS * HEAD_DIM
ODD_SPLIT = (FOX_HEADS * HEAD_DIM, FOX_HEADS * HEAD_DIM, FOX_HEADS * HEAD_DIM, FOX_HEADS)
ODD_IN = 3 * FOX_HEADS * HEAD_DIM + FOX_HEADS
ODD_MIX = FOX_HEADS * HEAD_DIM

kernel_name = "hybrid_mla_swa_fox_deepnorm"


def _split(h, sizes):
    out, o = [], 0
    for n in sizes:
        out.append(h[..., o:o + n])
        o += n
    return out


def _layer_norm(x, g, b):
    xf = x.astype(jnp.float32)
    mu = jnp.mean(xf, -1, keepdims=True)
    var = jnp.mean(jnp.square(xf - mu), -1, keepdims=True)
    y = (xf - mu) * lax.rsqrt(var + NORM_EPS)
    return (y * g.astype(jnp.float32) + b.astype(jnp.float32)).astype(x.dtype)


def _rms_norm(x, g):
    xf = x.astype(jnp.float32)
    y = xf * lax.rsqrt(jnp.mean(jnp.square(xf), -1, keepdims=True) + NORM_EPS)
    return (y * g.astype(jnp.float32)).astype(x.dtype)


def _rope_tables(seq_len, dim):
    inv = 1.0 / (ROPE_THETA ** (jnp.arange(0, dim, 2, dtype=jnp.float32) / dim))
    ang = jnp.arange(seq_len, dtype=jnp.float32)[:, None] * inv[None, :]
    return jnp.cos(ang), jnp.sin(ang)


def _apply_rope(x, cos, sin):
    x1, x2 = jnp.split(x.astype(jnp.float32), 2, axis=-1)
    c = cos[:, None, :]
    s = sin[:, None, :]
    return jnp.concatenate([x1 * c - x2 * s, x2 * c + x1 * s], -1).astype(x.dtype)


def _t5_bucket(dist):
    exact = REL_BUCKETS // 2
    d = jnp.maximum(dist, 1).astype(jnp.float32)
    large = exact + (jnp.log(d / exact) / math.log(REL_MAX_DIST / exact)
                     * (REL_BUCKETS - exact)).astype(jnp.int32)
    large = jnp.minimum(large, REL_BUCKETS - 1)
    return jnp.where(dist < exact, dist, large)


def _mla_attend(q_nope, q_rope, k_nope, k_rope, v):
    B, S, H, _ = q_nope.shape
    nb = S // BLOCK_Q
    scale = (MLA_NOPE + MLA_ROPE) ** -0.5
    qn = q_nope.reshape(B, nb, BLOCK_Q, H, MLA_NOPE).transpose(1, 0, 2, 3, 4)
    qr = q_rope.reshape(B, nb, BLOCK_Q, H, MLA_ROPE).transpose(1, 0, 2, 3, 4)
    kpos = jnp.arange(S)

    def block(args):
        i, qn_b, qr_b = args
        s = (jnp.einsum('bqhd,bkhd->bhqk', qn_b, k_nope, preferred_element_type=jnp.float32)
             + jnp.einsum('bqhd,bkd->bhqk', qr_b, k_rope, preferred_element_type=jnp.float32)) * scale
        qpos = i * BLOCK_Q + jnp.arange(BLOCK_Q)
        s = jnp.where(kpos[None, :] <= qpos[:, None], s, NEG_INF)
        w = jax.nn.softmax(s, axis=-1).astype(v.dtype)
        return jnp.einsum('bhqk,bkhd->bqhd', w, v)

    out = lax.map(block, (jnp.arange(nb), qn, qr))
    return out.transpose(1, 0, 2, 3, 4).reshape(B, S, H * MLA_V)


def _swa_attend(q, k, v, sinks, rel_bias):
    B, S, H, d = q.shape
    KVH = k.shape[2]
    G = H // KVH
    nb = S // BLOCK_Q
    qb = q.reshape(B, nb, BLOCK_Q, KVH, G, d)

    def band(t):
        tb = t.reshape(B, nb, BLOCK_Q, KVH, d)
        prev = jnp.pad(tb, ((0, 0), (1, 0), (0, 0), (0, 0), (0, 0)))[:, :-1]
        return jnp.concatenate([prev, tb], axis=2)

    kb, vb = band(k), band(v)
    s = jnp.einsum('bnqkgd,bnskd->bnkgqs', qb, kb, preferred_element_type=jnp.float32) * (d ** -0.5)
    a = jnp.arange(BLOCK_Q)[:, None]
    col = jnp.arange(2 * BLOCK_Q)[None, :]
    dist = a + BLOCK_Q - col
    in_win = (dist >= 0) & (dist < SWA_WINDOW)
    pad = (jnp.arange(nb)[:, None, None] == 0) & (col < BLOCK_Q)[None]
    valid = in_win[None] & ~pad
    bias = rel_bias[_t5_bucket(jnp.maximum(dist, 0))].astype(jnp.float32)
    bias = bias.transpose(2, 0, 1).reshape(KVH, G, BLOCK_Q, 2 * BLOCK_Q)
    s = jnp.where(valid[None, :, None, None], s + bias, NEG_INF)
    sink = jnp.broadcast_to(sinks.astype(jnp.float32).reshape(1, 1, KVH, G, 1, 1), s.shape[:-1] + (1,))
    w = jax.nn.softmax(jnp.concatenate([s, sink], axis=-1), axis=-1)[..., :-1].astype(v.dtype)
    out = jnp.einsum('bnkgqs,bnskd->bnqkgd', w, vb)
    return out.reshape(B, S, H * d)


def _fox_attend(q, k, v, log_f):
    B, S, H, d = q.shape
    nb = S // BLOCK_Q
    c = jnp.cumsum(log_f, axis=1)
    cq = c.reshape(B, nb, BLOCK_Q, H).transpose(1, 0, 3, 2)
    ck = c.transpose(0, 2, 1)
    qb = q.reshape(B, nb, BLOCK_Q, H, d).transpose(1, 0, 2, 3, 4)
    kpos = jnp.arange(S)

    def block(args):
        i, q_b, cq_b = args
        s = jnp.einsum('bqhd,bkhd->bhqk', q_b, k, preferred_element_type=jnp.float32) * (d ** -0.5)
        s = s + cq_b[..., :, None] - ck[:, :, None, :]
        qpos = i * BLOCK_Q + jnp.arange(BLOCK_Q)
        s = jnp.where(kpos[None, :] <= qpos[:, None], s, NEG_INF)
        w = jax.nn.softmax(s, axis=-1).astype(v.dtype)
        return jnp.einsum('bhqk,bkhd->bqhd', w, v)

    out = lax.map(block, (jnp.arange(nb), qb, cq))
    return out.transpose(1, 0, 2, 3, 4).reshape(B, S, H * d)


def _even_mixer(x, w_in, q_norm, w_uq, kv_norm, w_ukv, sinks, w_out, rel_bias, cos, sin):
    B, S, _ = x.shape
    h = x @ w_in
    c_q, c_kv, k_rope, q_s, k_s, v_s = _split(h, EVEN_SPLIT)
    q = (_rms_norm(c_q, q_norm) @ w_uq).reshape(B, S, MLA_HEADS, MLA_NOPE + MLA_ROPE)
    q_nope = q[..., :MLA_NOPE]
    q_rope = _apply_rope(q[..., MLA_NOPE:], cos, sin)
    kv = (_rms_norm(c_kv, kv_norm) @ w_ukv).reshape(B, S, MLA_HEADS, MLA_NOPE + MLA_V)
    k_nope, v = kv[..., :MLA_NOPE], kv[..., MLA_NOPE:]
    k_rope = _apply_rope(k_rope[:, :, None, :], cos, sin)[:, :, 0]
    o_mla = _mla_attend(q_nope, q_rope, k_nope, k_rope, v)
    o_swa = _swa_attend(q_s.reshape(B, S, SWA_HEADS, HEAD_DIM),
                        k_s.reshape(B, S, SWA_KV_HEADS, HEAD_DIM),
                        v_s.reshape(B, S, SWA_KV_HEADS, HEAD_DIM), sinks, rel_bias)
    return jnp.concatenate([o_mla, o_swa], axis=-1) @ w_out


def _odd_mixer(x, w_in, b_f, w_out):
    B, S, _ = x.shape
    q, k, v, f = _split(x @ w_in, ODD_SPLIT)
    log_f = jax.nn.log_sigmoid((f + b_f).astype(jnp.float32))
    o = _fox_attend(q.reshape(B, S, FOX_HEADS, HEAD_DIM), k.reshape(B, S, FOX_HEADS, HEAD_DIM),
                    v.reshape(B, S, FOX_HEADS, HEAD_DIM), log_f)
    return o @ w_out


def _sq_relu_mlp(x, w_up, w_down):
    return jnp.square(jax.nn.relu(x @ w_up)) @ w_down


def setup_inputs(seed: int = 0) -> dict:
    key = jax.random.key(seed)
    ks = jax.random.split(key, 24)
    nrm = jax.random.normal
    f32 = jnp.float32
    return {
        "x": nrm(ks[0], (BATCH, SEQ, D_MODEL), f32),
        "p": nrm(ks[1], (DEPTH, BATCH, SEQ, D_PLE), f32),
        "rel_bias": 0.5 * nrm(ks[2], (REL_BUCKETS, SWA_HEADS), f32),
        "ev_w_in": nrm(ks[3], (N_EVEN, D_MODEL, EVEN_IN), f32) * D_MODEL ** -0.5,
        "ev_q_norm": 1.0 + 0.02 * nrm(ks[4], (N_EVEN, MLA_Q_LORA), f32),
        "ev_w_uq": nrm(ks[5], (N_EVEN, MLA_Q_LORA, MLA_HEADS * (MLA_NOPE + MLA_ROPE)), f32) * MLA_Q_LORA ** -0.5,
        "ev_kv_norm": 1.0 + 0.02 * nrm(ks[6], (N_EVEN, MLA_KV_LORA), f32),
        "ev_w_ukv": nrm(ks[7], (N_EVEN, MLA_KV_LORA, MLA_HEADS * (MLA_NOPE + MLA_V)), f32) * MLA_KV_LORA ** -0.5,
        "ev_sinks": 0.5 * nrm(ks[8], (N_EVEN, SWA_HEADS), f32),
        "ev_w_out": nrm(ks[9], (N_EVEN, EVEN_MIX, D_MODEL), f32) * (EVEN_MIX ** -0.5 * DN_BETA),
        "od_w_in": nrm(ks[10], (N_ODD, D_MODEL, ODD_IN), f32) * D_MODEL ** -0.5,
        "od_b_f": jax.random.uniform(ks[11], (N_ODD, FOX_HEADS), f32, 1.0, 4.0),
        "od_w_out": nrm(ks[12], (N_ODD, ODD_MIX, D_MODEL), f32) * (ODD_MIX ** -0.5 * DN_BETA),
        "ln1_g": 1.0 + 0.02 * nrm(ks[13], (DEPTH, D_MODEL), f32),
        "ln1_b": 0.02 * nrm(ks[14], (DEPTH, D_MODEL), f32),
        "w_up": nrm(ks[15], (DEPTH, D_MODEL, D_FF), f32) * D_MODEL ** -0.5,
        "w_down": nrm(ks[16], (DEPTH, D_FF, D_MODEL), f32) * (D_FF ** -0.5 * DN_BETA),
        "ln2_g": 1.0 + 0.02 * nrm(ks[17], (DEPTH, D_MODEL), f32),
        "ln2_b": 0.02 * nrm(ks[18], (DEPTH, D_MODEL), f32),
        "ple_w_proj": nrm(ks[19], (DEPTH, D_PLE, D_MODEL), f32) * D_PLE ** -0.5,
        "ple_w_gate": nrm(ks[20], (DEPTH, D_MODEL, D_MODEL), f32) * D_MODEL ** -0.5,
        "ple_b_gate": 0.02 * nrm(ks[21], (DEPTH, D_MODEL), f32),
    }


def reference(x, p, rel_bias, ev_w_in, ev_q_norm, ev_w_uq, ev_kv_norm, ev_w_ukv, ev_sinks, ev_w_out,
              od_w_in, od_b_f, od_w_out, ln1_g, ln1_b, w_up, w_down, ln2_g, ln2_b,
              ple_w_proj, ple_w_gate, ple_b_gate):
    S = x.shape[1]
    cos, sin = _rope_tables(S, MLA_ROPE)
    for i in range(DEPTH):
        j = i // 2
        if i % 2 == 0:
            m = _even_mixer(x, ev_w_in[j], ev_q_norm[j], ev_w_uq[j], ev_kv_norm[j], ev_w_ukv[j],
                            ev_sinks[j], ev_w_out[j], rel_bias, cos, sin)
        else:
            m = _odd_mixer(x, od_w_in[j], od_b_f[j], od_w_out[j])
        x = _layer_norm(DN_ALPHA * x + m, ln1_g[i], ln1_b[i])
        x = _layer_norm(DN_ALPHA * x + _sq_relu_mlp(x, w_up[i], w_down[i]), ln2_g[i], ln2_b[i])
        gate = jax.nn.sigmoid(x @ ple_w_gate[i] + ple_b_gate[i])
        x = x + gate * (p[i] @ ple_w_proj[i])
    return x
```

```cpp
#include <hip/hip_runtime.h>
#include <hip/hip_cooperative_groups.h>
#include <cstdio>
#include <cstdint>
namespace cg = cooperative_groups;

#define LAS __attribute__((address_space(3)))
typedef unsigned short bf16_t;
typedef short bf16x8 __attribute__((ext_vector_type(8)));
typedef float f32x4 __attribute__((ext_vector_type(4)));
typedef float f32x16 __attribute__((ext_vector_type(16)));
typedef unsigned u32x4 __attribute__((ext_vector_type(4)));
typedef unsigned u32x2 __attribute__((ext_vector_type(2)));
typedef float f32x2_t __attribute__((ext_vector_type(2)));
typedef __bf16 bf16x2_t __attribute__((ext_vector_type(2)));

constexpr int M = 65536, SEQ = 2048, NBATCH = 32, D = 1024, FF = 4096, DPLE = 256, DEPTH = 4;
constexpr int EIN = 1440, EINP = 1536, OIN = 3088, OINP = 3328;
constexpr float ALPHA = 1.6817928305074290f;
constexpr float LN_EPS = 1e-5f;
constexpr float LOG2E = 1.4426950408889634f;
constexpr int NTHREADS = 512, NWAVES = 8;

constexpr size_t MiB = 1u << 20;
constexpr size_t WS_COS = 0, WS_SIN = 128 * 1024, WS_BIAST = 256 * 1024;
constexpr size_t WS_RSTDQ = 1 * MiB, WS_RSTDKV = 1 * MiB + 256 * 1024;
constexpr size_t WS_LF = 2 * MiB, WS_CK = 6 * MiB, WS_KR = 10 * MiB, WS_W = 14 * MiB;
constexpr size_t WS_PB = 120 * MiB, WS_XB0 = 152 * MiB, WS_XB1 = 280 * MiB, WS_ACT = 408 * MiB, WS_END = 920 * MiB;
constexpr size_t WE_IN = 0, WE_UQ = (size_t)EINP * D, WE_UKV = WE_UQ + 768 * 384, WE_OUT = WE_UKV + 1024 * 256, WE_SZ = WE_OUT + (size_t)D * D;
constexpr size_t WO_IN = 0, WO_OUT = (size_t)OINP * D, WO_SZ = WO_OUT + (size_t)D * D;
constexpr size_t WC_UP = 0, WC_DOWN = (size_t)FF * D, WC_G = 2 * (size_t)FF * D, WC_P = WC_G + (size_t)D * D, WC_SZ = WC_P + (size_t)D * DPLE;
constexpr size_t W_EVEN0 = 0, W_ODD0 = 2 * WE_SZ, W_COM0 = W_ODD0 + 2 * WO_SZ, W_TOTAL = W_COM0 + 4 * WC_SZ;
static_assert(WS_W + W_TOTAL * 2 <= WS_PB, "weights fit");
constexpr size_t ACT_H = 0, ACT_Q = 192 * MiB, ACT_KV = 288 * MiB;

__device__ __forceinline__ unsigned pk2(float lo, float hi) { f32x2_t v = {lo, hi}; bf16x2_t b = __builtin_convertvector(v, bf16x2_t); return __builtin_bit_cast(unsigned, b); }
__device__ __forceinline__ float bf2f(unsigned short u) { return __uint_as_float(((unsigned)u) << 16); }
__device__ __forceinline__ float bflo(unsigned u) { return __uint_as_float(u << 16); }
__device__ __forceinline__ float bfhi(unsigned u) { return __uint_as_float(u & 0xffff0000u); }
#define LDS_WAIT() asm volatile("s_waitcnt lgkmcnt(0)" ::: "memory")
__device__ __forceinline__ float wave_sum(float v) {
#pragma unroll
    for (int o = 1; o < 64; o <<= 1) v += __shfl_xor(v, o);
    return v;
}

namespace pg8 {
constexpr int BM = 256, BK = 64, HALF = 128, HTB = HALF * BK * 2, STAGE_BYTES = 8 * HTB, NXCD = 8, WGM = 8;
__device__ __forceinline__ int lds_byte(int r, int c) { const int st = (r >> 4) * 2 + (c >> 5), rr = r & 15, cc = c & 31, ob = rr * 64 + cc * 2; return st * 1024 + (ob ^ (((ob >> 9) & 1) << 5)); }
__device__ __forceinline__ void stage_rc(int b, int& R, int& C) { const int st = b / 1024, sb = b % 1024, swz = sb ^ (((sb >> 9) & 1) << 5); R = (st >> 1) * 16 + swz / 64; C = (st & 1) * 32 + (swz % 64) / 2; }
__device__ __forceinline__ int perm32(int rho) { const int n = rho >> 4, i = rho & 15; return 8 * (i >> 2) + 4 * n + (i & 3); }

struct Unit { int pm, pn; };
struct Gemm { const bf16_t* A; const bf16_t* Bt; int M, N, K, lda; };

struct StaticOrder {
    int nM, nN, nwg, G, c;
    __device__ void init(int M_, int N_, int G_, int c_) { nM = M_ / BM; nN = N_ / BM; nwg = nM * nN; G = G_; c = c_; }
    __device__ bool next(int i, Unit& u) const {
        const long L = (long)i * G + c; if (L >= nwg) return false;
        int wgid = (int)L; { const int q = nwg / NXCD, r = nwg % NXCD, xcd = wgid % NXCD, off = wgid / NXCD; wgid = (xcd < r ? xcd * (q + 1) : r * (q + 1) + (xcd - r) * q) + off; }
        const int nig = WGM * nN, gid = wgid / nig, fm = gid * WGM, gsz = (nM - fm) < WGM ? (nM - fm) : WGM;
        u.pm = fm + ((wgid % nig) % gsz); u.pn = (wgid % nig) / gsz; return true;
    }
};


template <int ACT  , bool ODDF> struct EpiBf16 {
    static constexpr bool PERM = true;
    bf16_t* O; int ldc; float* lf; const float* bf;
    __device__ __forceinline__ void operator()(const f32x4 (&acc)[2][2][4][2], const Unit& u, int wr, int wc, int fr_, int fq_) const {
        int t_ = threadIdx.x; asm volatile("" : "+v"(t_)); const int fr = t_ & 15, fq = (t_ >> 4) & 3; (void)fr_; (void)fq_;
        const int row0 = u.pm * BM + wr * 64 + fr;
        if (ODDF && u.pn == 12) {
            if (wc == 0 && fq < 2) {
                const f32x4 b0 = *(const f32x4*)(bf + 8 * fq), b1 = *(const f32x4*)(bf + 8 * fq + 4);
#pragma unroll
                for (int ai = 0; ai < 2; ++ai)
#pragma unroll
                    for (int m = 0; m < 4; ++m) {
                        const f32x4 z0 = acc[ai][0][m][0] + b0, z1 = acc[ai][0][m][1] + b1; f32x4 o0, o1;
#pragma unroll
                        for (int e = 0; e < 4; ++e) { o0[e] = fminf(z0[e], 0.f) - log1pf(expf(-fabsf(z0[e]))); o1[e] = fminf(z1[e], 0.f) - log1pf(expf(-fabsf(z1[e]))); }
                        float* p = lf + (size_t)(row0 + ai * HALF + m * 16) * 16 + 8 * fq;
                        *(f32x4*)p = o0; *(f32x4*)(p + 4) = o1;
                    }
            }
            return;
        }
        const int col0 = u.pn * BM + wc * 32 + 8 * fq;
#pragma unroll
        for (int ai = 0; ai < 2; ++ai)
#pragma unroll
            for (int m = 0; m < 4; ++m) { bf16_t* rowp = O + (size_t)(row0 + ai * HALF + m * 16) * ldc + col0;
#pragma unroll
                for (int bj = 0; bj < 2; ++bj) { f32x4 v0 = acc[ai][bj][m][0], v1 = acc[ai][bj][m][1];
                    if (ACT == 1) {
#pragma unroll
                        for (int e = 0; e < 4; ++e) { const float a = fmaxf(v0[e], 0.f), b = fmaxf(v1[e], 0.f); v0[e] = a * a; v1[e] = b * b; } }
                    u32x4 w; w.x = pk2(v0[0], v0[1]); w.y = pk2(v0[2], v0[3]); w.z = pk2(v1[0], v1[1]); w.w = pk2(v1[2], v1[3]);
                    *(u32x4*)(rowp + bj * HALF) = w; } }
    }
};
template <bool ROPE> struct EpiScale {
    static constexpr bool PERM = true;
    bf16_t* O; int ldc; const float* rstd; const float* cosT; const float* sinT;
    __device__ __forceinline__ void operator()(const f32x4 (&acc)[2][2][4][2], const Unit& u, int wr, int wc, int fr_, int fq_) const {
        int t_ = threadIdx.x; asm volatile("" : "+v"(t_)); const int fr = t_ & 15, fq = (t_ >> 4) & 3; (void)fr_; (void)fq_;
        const int row0 = u.pm * BM + wr * 64 + fr;
        const int col0 = u.pn * BM + wc * 32 + 8 * fq;
#pragma unroll
        for (int ai = 0; ai < 2; ++ai)
#pragma unroll
            for (int m = 0; m < 4; ++m) { const int row = row0 + ai * HALF + m * 16; const float rs = rstd[row]; bf16_t* rowp = O + (size_t)row * ldc + col0;
#pragma unroll
                for (int bj = 0; bj < 2; ++bj) { f32x4 v0 = acc[ai][bj][m][0] * rs, v1 = acc[ai][bj][m][1] * rs;
                    if (ROPE) {
                        const int grp = (u.pn * BM + bj * HALF + wc * 32) >> 5;
                        if (grp % 3 == 2) {
                            f32x4 p0, p1;
#pragma unroll
                            for (int e = 0; e < 4; ++e) { p0[e] = __shfl_xor(v0[e], 32); p1[e] = __shfl_xor(v1[e], 32); }
                            const int pos = row & (SEQ - 1); const float* ct = cosT + pos * 16 + 8 * (fq & 1); const float* st = sinT + pos * 16 + 8 * (fq & 1);
                            const f32x4 c0 = *(const f32x4*)ct, c1 = *(const f32x4*)(ct + 4), s0 = *(const f32x4*)st, s1 = *(const f32x4*)(st + 4);
                            if (fq < 2) { v0 = v0 * c0 - p0 * s0; v1 = v1 * c1 - p1 * s1; } else { v0 = v0 * c0 + p0 * s0; v1 = v1 * c1 + p1 * s1; }
                        }
                    }
                    u32x4 w; w.x = pk2(v0[0], v0[1]); w.y = pk2(v0[2], v0[3]); w.z = pk2(v1[0], v1[1]); w.w = pk2(v1[2], v1[3]);
                    *(u32x4*)(rowp + bj * HALF) = w; } }
    }
};
struct EpiResid {
    static constexpr bool PERM = false;
    const float* xres; float* out;
    __device__ __forceinline__ void operator()(const f32x4 (&acc)[2][2][4][2], const Unit& u, int wr, int wc, int fr_, int fq_) const {
        int t_ = threadIdx.x; asm volatile("" : "+v"(t_)); const int fr = t_ & 15, fq = (t_ >> 4) & 3; (void)fr_; (void)fq_;
        const int col0 = u.pn * BM + wc * 32 + 4 * fq;
#pragma unroll
        for (int ai = 0; ai < 2; ++ai)
#pragma unroll
            for (int m = 0; m < 4; ++m) { const size_t off = (size_t)(u.pm * BM + ai * HALF + wr * 64 + m * 16 + fr) * D + col0;
#pragma unroll
                for (int bj = 0; bj < 2; ++bj)
#pragma unroll
                    for (int n = 0; n < 2; ++n) { const f32x4 xs = *(const f32x4*)(xres + off + bj * HALF + n * 16); *(f32x4*)(out + off + bj * HALF + n * 16) = xs * ALPHA + acc[ai][bj][m][n]; } }
    }
};
struct EpiGate {
    static constexpr bool PERM = false;
    float* x; bf16_t* ppx; const float* bg;
    __device__ __forceinline__ void operator()(const f32x4 (&acc)[2][2][4][2], const Unit& u, int wr, int wc, int fr_, int fq_) const {
        int t_ = threadIdx.x; asm volatile("" : "+v"(t_)); const int fr = t_ & 15, fq = (t_ >> 4) & 3; (void)fr_; (void)fq_;
        const int col0 = u.pn * BM + wc * 32 + 4 * fq;
#pragma unroll
        for (int bj = 0; bj < 2; ++bj)
#pragma unroll
            for (int n = 0; n < 2; ++n) { const f32x4 bv = *(const f32x4*)(bg + col0 + bj * HALF + n * 16);
#pragma unroll
                for (int ai = 0; ai < 2; ++ai)
#pragma unroll
                    for (int m = 0; m < 4; ++m) { const size_t off = (size_t)(u.pm * BM + ai * HALF + wr * 64 + m * 16 + fr) * D + col0 + bj * HALF + n * 16;
                        const f32x4 xs = *(const f32x4*)(x + off); const u32x2 pw = *(const u32x2*)(ppx + off);
                        const f32x4 z = acc[ai][bj][m][n] + bv; f32x4 o;
                        o[0] = xs[0] + bflo(pw.x) / (1.f + __expf(-z[0])); o[1] = xs[1] + bfhi(pw.x) / (1.f + __expf(-z[1]));
                        o[2] = xs[2] + bflo(pw.y) / (1.f + __expf(-z[2])); o[3] = xs[3] + bfhi(pw.y) / (1.f + __expf(-z[3]));
                        *(f32x4*)(x + off) = o; u32x2 w; w.x = pk2(o[0], o[1]); w.y = pk2(o[2], o[3]); *(u32x2*)(ppx + off) = w; } }
    }
};

template <class Epi, bool ALIGN_EPI>
__device__ __forceinline__ void gemm_phase(LAS unsigned char* lds, const Gemm g, const StaticOrder& S, const Epi& E) {
    int tid = threadIdx.x; asm volatile("" : "+v"(tid));
    const int wid = __builtin_amdgcn_readfirstlane(tid >> 6), lane = tid & 63, wr = wid >> 2, wc = wid & 3, fr = lane & 15, fq = lane >> 4;
    const int K = g.K, nt = K / BK, lda = g.lda;
    unsigned voffA[2], voffB[2];
#pragma unroll
    for (int i = 0; i < 2; ++i) { int R, C; stage_rc(tid * 16 + i * 8192, R, C); const int Rb = Epi::PERM ? ((R & ~31) + perm32(R & 31)) : R;
        voffA[i] = (unsigned)(R * lda + C) * 2u; voffB[i] = (unsigned)(Rb * K + C) * 2u; }
    const size_t kstep = (size_t)(BK * 2);
    const size_t hstepA = (size_t)HALF * lda * 2, hstepB = (size_t)HALF * K * 2;
    const size_t tstepA = 2 * hstepA, tstepB = 2 * hstepB;
    const unsigned ldsw = (unsigned)wid * 1024u;
    const int aoff = lds_byte(wr * 64 + fr, fq * 8), boff = lds_byte(wc * 32 + fr, fq * 8);
#define PG8_SA(b, h) (((b) * 2 + (h)) * HTB)
#define PG8_SB(b, h) ((4 + (b) * 2 + (h)) * HTB)
#define PG8_STAGE(bufoff, gbase, voff) do { _Pragma("unroll") for (int _i = 0; _i < 2; ++_i) \
        __builtin_amdgcn_global_load_lds((const unsigned*)((const char*)(gbase) + (voff)[_i]), (LAS unsigned*)(lds + (bufoff) + ldsw + _i * 8192), 16, 0, 0); } while (0)
#define PG8_LDA(dst, b, h) do { _Pragma("unroll") for (int m = 0; m < 4; ++m) _Pragma("unroll") for (int k = 0; k < 2; ++k) dst[m][k] = *(const LAS bf16x8*)(lds + PG8_SA(b, h) + aoff + m * 2048 + k * 1024); } while (0)
#define PG8_LDB(dst, b, h) do { _Pragma("unroll") for (int n = 0; n < 2; ++n) _Pragma("unroll") for (int k = 0; k < 2; ++k) dst[n][k] = *(const LAS bf16x8*)(lds + PG8_SB(b, h) + boff + n * 2048 + k * 1024); } while (0)
#define PG8_MMA(ai, bj, At, Bt) do { __builtin_amdgcn_s_setprio(1); _Pragma("unroll") for (int m = 0; m < 4; ++m) _Pragma("unroll") for (int n = 0; n < 2; ++n) _Pragma("unroll") for (int k = 0; k < 2; ++k) \
        acc[ai][bj][m][n] = __builtin_amdgcn_mfma_f32_16x16x32_bf16(Bt[n][k], At[m][k], acc[ai][bj][m][n], 0, 0, 0); __builtin_amdgcn_s_setprio(0); } while (0)
#define PG8_WAIT_V(n) asm volatile("s_waitcnt vmcnt(" #n ")" ::: "memory")
#define PG8_WAIT_L(n) asm volatile("s_waitcnt lgkmcnt(" #n ")" ::: "memory")
#define PG8_BAR __builtin_amdgcn_s_barrier()
#define PG8_SCHED __builtin_amdgcn_sched_barrier(0)
    Unit cur, nxt; int ui = 0;
    if (!S.next(0, cur)) return;
    f32x4 acc[2][2][4][2];
#pragma unroll
    for (int a = 0; a < 2; ++a)
#pragma unroll
        for (int b = 0; b < 2; ++b)
#pragma unroll
            for (int m = 0; m < 4; ++m)
#pragma unroll
                for (int n = 0; n < 2; ++n) acc[a][b][m][n] = (f32x4){0.f, 0.f, 0.f, 0.f};
    bf16x8 At[4][2], B0[2][2], B1[2][2];
    const char* cA = (const char*)g.A + (size_t)cur.pm * tstepA; const char* cB = (const char*)g.Bt + (size_t)cur.pn * tstepB;
    PG8_STAGE(PG8_SB(0, 0), cB, voffB); PG8_STAGE(PG8_SB(0, 1), cB + hstepB, voffB); PG8_STAGE(PG8_SA(0, 0), cA, voffA); PG8_STAGE(PG8_SA(0, 1), cA + hstepA, voffA);
    if (wr == 1) PG8_BAR;
    PG8_WAIT_V(2); PG8_BAR;
    PG8_STAGE(PG8_SB(1, 0), cB + kstep, voffB); PG8_STAGE(PG8_SA(1, 0), cA + kstep, voffA); PG8_STAGE(PG8_SB(1, 1), cB + hstepB + kstep, voffB);
    PG8_WAIT_V(6); PG8_BAR;
    for (;;) {
        const bool has_next = S.next(ui + 1, nxt);
        const char* nA = has_next ? (const char*)g.A + (size_t)nxt.pm * tstepA : cA; const char* nB = has_next ? (const char*)g.Bt + (size_t)nxt.pn * tstepB : cB;
        for (int t = 0; t < nt; t += 2) {
            const bool last = (t == nt - 2);
            const char* a1 = cA + (size_t)(t + 1) * kstep;
            const char* a2 = last ? nA : cA + (size_t)(t + 2) * kstep; const char* b2 = last ? nB : cB + (size_t)(t + 2) * kstep;
            const char* a3 = a2 + kstep; const char* b3 = b2 + kstep;
            PG8_LDB(B0, 0, 0); PG8_LDB(B1, 0, 1); PG8_SCHED; PG8_LDA(At, 0, 0); PG8_STAGE(PG8_SA(1, 1), a1 + hstepA, voffA);
            PG8_WAIT_V(8); PG8_WAIT_L(0); PG8_BAR; PG8_MMA(0, 0, At, B0); PG8_MMA(0, 1, At, B1); PG8_BAR; PG8_SCHED;
            PG8_LDA(At, 0, 1); PG8_STAGE(PG8_SB(0, 0), b2, voffB); PG8_STAGE(PG8_SB(0, 1), b2 + hstepB, voffB); PG8_STAGE(PG8_SA(0, 0), a2, voffA);
            PG8_WAIT_V(8); PG8_WAIT_L(0); PG8_BAR; PG8_MMA(1, 0, At, B0); PG8_MMA(1, 1, At, B1); PG8_BAR; PG8_SCHED;
            PG8_LDB(B0, 1, 0); PG8_LDB(B1, 1, 1); PG8_SCHED; PG8_LDA(At, 1, 0); PG8_STAGE(PG8_SA(0, 1), a2 + hstepA, voffA);
            PG8_WAIT_V(8); PG8_WAIT_L(0); PG8_BAR; PG8_MMA(0, 0, At, B0); PG8_MMA(0, 1, At, B1); PG8_BAR; PG8_SCHED;
            PG8_LDA(At, 1, 1); PG8_STAGE(PG8_SB(1, 0), b3, voffB); PG8_STAGE(PG8_SB(1, 1), b3 + hstepB, voffB); PG8_STAGE(PG8_SA(1, 0), a3, voffA);
            PG8_WAIT_V(8); PG8_WAIT_L(0); PG8_BAR; PG8_MMA(1, 0, At, B0); PG8_MMA(1, 1, At, B1); PG8_BAR; PG8_SCHED;
        }
        if constexpr (ALIGN_EPI) { if (wr == 0) PG8_BAR; }
        E(acc, cur, wr, wc, fr, fq);
        if (!has_next) break;
#pragma unroll
        for (int a = 0; a < 2; ++a)
#pragma unroll
            for (int b = 0; b < 2; ++b)
#pragma unroll
                for (int m = 0; m < 4; ++m)
#pragma unroll
                    for (int n = 0; n < 2; ++n) acc[a][b][m][n] = (f32x4){0.f, 0.f, 0.f, 0.f};
        cur = nxt; cA = nA; cB = nB; ++ui;
        if constexpr (ALIGN_EPI) { if (wr == 1) PG8_BAR; }
    }
    PG8_WAIT_V(0);
    if constexpr (!ALIGN_EPI) { if (wr == 0) PG8_BAR; }
    PG8_BAR;
#undef PG8_SA
#undef PG8_SB
#undef PG8_STAGE
#undef PG8_LDA
#undef PG8_LDB
#undef PG8_MMA
#undef PG8_WAIT_V
#undef PG8_WAIT_L
#undef PG8_BAR
#undef PG8_SCHED
}
}

namespace att {
constexpr int BUFB = 24576, VOFF = 13312, BOFF = 13312 + 9216, TABOFF = 2 * BUFB;
constexpr int VPB = 144;
__device__ __forceinline__ int crow(int r, int hi) { return (r & 3) + 8 * (r >> 2) + 4 * hi; }
struct Tens {
    const bf16_t* Q; int qpitch;
    const bf16_t* KA; int kpitch;
    const bf16_t* KB;
    const bf16_t* V; int vpitch;
    const float* kbias;
    bf16_t* O;
    float scale_l2; float sink_l2;
};
template <int MODE>
__device__ __forceinline__ void unit(LAS unsigned char* lds, const Tens& T, int qb) {
    constexpr int DQK = (MODE == 0) ? 96 : 64, NDS = DQK / 16, KPB = (DQK + 8) * 2;
    int tid = threadIdx.x; asm volatile("" : "+v"(tid));
    const int lane = tid & 63, r32 = lane & 31, hi = lane >> 5, w = __builtin_amdgcn_readfirstlane(tid >> 6);
    const int q0 = qb * 256, qw = q0 + 32 * w, qg = qw + r32;
    const int t_lo = (MODE == 2) ? (4 * qb - 2 > 0 ? 4 * qb - 2 : 0) : 0, t_hi = 4 * qb + 3;
    const int ka_row = tid >> 3, ka_ch = tid & 7, kb_row = tid >> 2, kb_ch = tid & 3, v_kv = tid & 63, v_dc = tid >> 6;
    const int v_pos = (v_kv & ~12) | ((v_kv & 8) >> 1) | ((v_kv & 4) << 1);
    u32x4 rka, rkb = {0u, 0u, 0u, 0u}, rv; float rbias = 0.f;
#define ATT_LOAD(t) do { const int kv0_ = (t) * 64; \
        rka = *(const u32x4*)(T.KA + (size_t)(kv0_ + ka_row) * T.kpitch + 8 * ka_ch); \
        if (MODE == 0 && tid < 256) rkb = *(const u32x4*)(T.KB + (size_t)(kv0_ + kb_row) * 32 + 8 * kb_ch); \
        rv = *(const u32x4*)(T.V + (size_t)(kv0_ + v_kv) * T.vpitch + 8 * v_dc); \
        if (MODE == 1 && tid < 64) rbias = T.kbias[kv0_ + tid]; } while (0)
#define ATT_STORE(buf) do { LAS unsigned char* b_ = lds + (buf) * BUFB; \
        *(LAS u32x4*)(b_ + ka_row * KPB + ka_ch * 16) = rka; \
        if (MODE == 0 && tid < 256) *(LAS u32x4*)(b_ + kb_row * KPB + 128 + kb_ch * 16) = rkb; \
        { LAS unsigned short* vt_ = (LAS unsigned short*)(b_ + VOFF) + (8 * v_dc) * (VPB / 2) + v_pos; \
          vt_[0 * (VPB / 2)] = (unsigned short)(rv.x & 0xffffu); vt_[1 * (VPB / 2)] = (unsigned short)(rv.x >> 16); \
          vt_[2 * (VPB / 2)] = (unsigned short)(rv.y & 0xffffu); vt_[3 * (VPB / 2)] = (unsigned short)(rv.y >> 16); \
          vt_[4 * (VPB / 2)] = (unsigned short)(rv.z & 0xffffu); vt_[5 * (VPB / 2)] = (unsigned short)(rv.z >> 16); \
          vt_[6 * (VPB / 2)] = (unsigned short)(rv.w & 0xffffu); vt_[7 * (VPB / 2)] = (unsigned short)(rv.w >> 16); } \
        if (MODE == 1 && tid < 64) *(LAS float*)(b_ + BOFF + 4 * tid) = rbias; } while (0)
    ATT_LOAD(t_lo);
    bf16x8 qf[NDS];
#pragma unroll
    for (int ds = 0; ds < NDS; ++ds) qf[ds] = *(const bf16x8*)(T.Q + (size_t)qg * T.qpitch + 16 * ds + 8 * hi);
    if (MODE == 2 && tid < 128) *(LAS float*)(lds + TABOFF + 4 * tid) = T.kbias[tid];
    ATT_STORE(0);
    __syncthreads();
    float mrun = (MODE == 2) ? T.sink_l2 : -INFINITY, lrun = (MODE == 2) ? (hi == 0 ? 1.f : 0.f) : 0.f;
    f32x16 o0, o1;
#pragma unroll
    for (int r = 0; r < 16; ++r) { o0[r] = 0.f; o1[r] = 0.f; }
    for (int t = t_lo; t <= t_hi; ++t) {
        const int cur = (t - t_lo) & 1, kv0 = t * 64;
        if (t < t_hi) ATT_LOAD(t + 1);
        bool part = (kv0 <= qw + 31);
        if (MODE == 2) part = part && (kv0 + 63 >= qw - 127);
        if (part) {
            const LAS unsigned char* kb_ = lds + cur * BUFB;
            f32x16 s0, s1;
#pragma unroll
            for (int r = 0; r < 16; ++r) { s0[r] = 0.f; s1[r] = 0.f; }
#pragma unroll
            for (int ds = 0; ds < NDS; ++ds) {
                const bf16x8 a0 = *(const LAS bf16x8*)(kb_ + r32 * KPB + ds * 32 + hi * 16);
                const bf16x8 a1 = *(const LAS bf16x8*)(kb_ + (32 + r32) * KPB + ds * 32 + hi * 16);
                s0 = __builtin_amdgcn_mfma_f32_32x32x16_bf16(a0, qf[ds], s0, 0, 0, 0);
                s1 = __builtin_amdgcn_mfma_f32_32x32x16_bf16(a1, qf[ds], s1, 0, 0, 0);
            }
            if (MODE == 1) {
                const LAS float* bb = (const LAS float*)(kb_ + BOFF);
#pragma unroll
                for (int g = 0; g < 4; ++g) { const f32x4 b0 = *(const LAS f32x4*)(bb + 8 * g + 4 * hi), b1 = *(const LAS f32x4*)(bb + 32 + 8 * g + 4 * hi);
#pragma unroll
                    for (int e = 0; e < 4; ++e) { s0[4 * g + e] = s0[4 * g + e] * T.scale_l2 + b0[e]; s1[4 * g + e] = s1[4 * g + e] * T.scale_l2 + b1[e]; } }
            } else {
#pragma unroll
                for (int r = 0; r < 16; ++r) { s0[r] *= T.scale_l2; s1[r] *= T.scale_l2; }
            }
            if (MODE == 2) {
                const LAS float* tab = (const LAS float*)(lds + TABOFF);
#pragma unroll
                for (int r = 0; r < 16; ++r) { const int kv = kv0 + crow(r, hi); const int d0 = qg - kv, d1 = d0 - 32;
                    const float t0 = tab[d0 & 127], t1 = tab[d1 & 127];
                    s0[r] = (d0 >= 0 && d0 < 128) ? s0[r] + t0 : -INFINITY; s1[r] = (d1 >= 0 && d1 < 128) ? s1[r] + t1 : -INFINITY; }
            } else if (kv0 + 63 > qw) {
#pragma unroll
                for (int r = 0; r < 16; ++r) { const int kv = kv0 + crow(r, hi); if (kv > qg) s0[r] = -INFINITY; if (kv + 32 > qg) s1[r] = -INFINITY; }
            }
            float rm = fmaxf(s0[0], s1[0]);
#pragma unroll
            for (int r = 1; r < 16; ++r) rm = fmaxf(rm, fmaxf(s0[r], s1[r]));
            rm = fmaxf(rm, __shfl_xor(rm, 32));
            const float mnew = fmaxf(mrun, rm), alpha = __builtin_amdgcn_exp2f(mrun - mnew);
            mrun = mnew;
            float rs = 0.f;
#pragma unroll
            for (int r = 0; r < 16; ++r) { s0[r] = __builtin_amdgcn_exp2f(s0[r] - mnew); s1[r] = __builtin_amdgcn_exp2f(s1[r] - mnew); rs += s0[r] + s1[r]; }
            lrun = lrun * alpha + rs;
#pragma unroll
            for (int r = 0; r < 16; ++r) { o0[r] *= alpha; o1[r] *= alpha; }
            bf16x8 pf[4];
#pragma unroll
            for (int j = 0; j < 4; ++j) { u32x4 p_;
                if (j < 2) { p_.x = pk2(s0[8 * j + 0], s0[8 * j + 1]); p_.y = pk2(s0[8 * j + 2], s0[8 * j + 3]); p_.z = pk2(s0[8 * j + 4], s0[8 * j + 5]); p_.w = pk2(s0[8 * j + 6], s0[8 * j + 7]); }
                else { const int jj = j - 2; p_.x = pk2(s1[8 * jj + 0], s1[8 * jj + 1]); p_.y = pk2(s1[8 * jj + 2], s1[8 * jj + 3]); p_.z = pk2(s1[8 * jj + 4], s1[8 * jj + 5]); p_.w = pk2(s1[8 * jj + 6], s1[8 * jj + 7]); }
                pf[j] = __builtin_bit_cast(bf16x8, p_); }
            const LAS unsigned char* vb_ = kb_ + VOFF;
#pragma unroll
            for (int j = 0; j < 4; ++j) {
                const bf16x8 v0 = *(const LAS bf16x8*)(vb_ + r32 * VPB + j * 32 + hi * 16);
                const bf16x8 v1 = *(const LAS bf16x8*)(vb_ + (32 + r32) * VPB + j * 32 + hi * 16);
                o0 = __builtin_amdgcn_mfma_f32_32x32x16_bf16(v0, pf[j], o0, 0, 0, 0);
                o1 = __builtin_amdgcn_mfma_f32_32x32x16_bf16(v1, pf[j], o1, 0, 0, 0);
            }
        }
        if (t < t_hi) ATT_STORE(cur ^ 1);
        __syncthreads();
    }
    const float ltot = lrun + __shfl_xor(lrun, 32), inv = 1.f / ltot;
    bf16_t* orow = T.O + (size_t)qg * D;
#pragma unroll
    for (int g = 0; g < 4; ++g) {
        u32x2 w0, w1;
        w0.x = pk2(o0[4 * g + 0] * inv, o0[4 * g + 1] * inv); w0.y = pk2(o0[4 * g + 2] * inv, o0[4 * g + 3] * inv);
        w1.x = pk2(o1[4 * g + 0] * inv, o1[4 * g + 1] * inv); w1.y = pk2(o1[4 * g + 2] * inv, o1[4 * g + 3] * inv);
        *(u32x2*)(orow + 8 * g + 4 * hi) = w0; *(u32x2*)(orow + 32 + 8 * g + 4 * hi) = w1;
    }
#undef ATT_LOAD
#undef ATT_STORE
}
}

struct Params {
    const float* x; const float* p; const float* rel_bias;
    const float* ev_w_in; const float* ev_q_norm; const float* ev_w_uq; const float* ev_kv_norm; const float* ev_w_ukv; const float* ev_sinks; const float* ev_w_out;
    const float* od_w_in; const float* od_b_f; const float* od_w_out;
    const float* ln1_g; const float* ln1_b; const float* w_up; const float* w_down; const float* ln2_g; const float* ln2_b;
    const float* ple_w_proj; const float* ple_w_gate; const float* ple_b_gate;
    float* out; unsigned char* ws;
};

__device__ __forceinline__ void prep_w(const float* W, int K, int ldw, int Nvalid, int Npad, bf16_t* WT, const float* kscale, LAS float* scr, int gw, int NGW, int lane) {
    const int nblk = Npad / 32, items = (K / 64) * nblk;
    for (int it = gw; it < items; it += NGW) {
        const int kb = it / nblk, nb = it % nblk, k0 = 64 * kb, n0 = 32 * nb;
#pragma unroll 8
        for (int i = 0; i < 32; ++i) { const int kk = 2 * i + (lane >> 5), n = n0 + (lane & 31);
            float v = (n < Nvalid) ? W[(size_t)(k0 + kk) * ldw + n] : 0.f; if (kscale) v *= kscale[k0 + kk]; scr[kk * 33 + (lane & 31)] = v; }
        LDS_WAIT();
        const int c = lane & 7;
#pragma unroll
        for (int j = 0; j < 4; ++j) { const int n = (lane >> 3) + 8 * j; const LAS float* s = scr + (8 * c) * 33 + n;
            u32x4 o; o.x = pk2(s[0 * 33], s[1 * 33]); o.y = pk2(s[2 * 33], s[3 * 33]); o.z = pk2(s[4 * 33], s[5 * 33]); o.w = pk2(s[6 * 33], s[7 * 33]);
            *(u32x4*)(WT + (size_t)(n0 + n) * K + k0 + 8 * c) = o; }
        LDS_WAIT();
    }
}
__device__ __forceinline__ void cvt_bf16(const float* src, bf16_t* dst, size_t n8, size_t gtid, size_t nthr) {
    for (size_t i = gtid; i < n8; i += nthr) { const f32x4 a = *(const f32x4*)(src + 8 * i), b = *(const f32x4*)(src + 8 * i + 4);
        u32x4 o; o.x = pk2(a[0], a[1]); o.y = pk2(a[2], a[3]); o.z = pk2(b[0], b[1]); o.w = pk2(b[2], b[3]); *(u32x4*)(dst + 8 * i) = o; }
}
__device__ __forceinline__ void ln_pass(float* R, bf16_t* XB, const float* g, const float* b, int gw, int NGW, int lane) {
    asm volatile("" : "+v"(lane));
    f32x4 gv[4], bv[4];
#pragma unroll
    for (int j = 0; j < 4; ++j) { gv[j] = *(const f32x4*)(g + 4 * lane + 256 * j); bv[j] = *(const f32x4*)(b + 4 * lane + 256 * j); }
    for (int row = gw; row < M; row += NGW) {
        float* xr = R + (size_t)row * D + 4 * lane;
        f32x4 v[4]; float s = 0.f;
#pragma unroll
        for (int j = 0; j < 4; ++j) { v[j] = *(const f32x4*)(xr + 256 * j); s += (v[j][0] + v[j][1]) + (v[j][2] + v[j][3]); }
        const float mean = wave_sum(s) * (1.f / D); float s2 = 0.f;
#pragma unroll
        for (int j = 0; j < 4; ++j) { v[j] = v[j] - mean; s2 += (v[j][0] * v[j][0] + v[j][1] * v[j][1]) + (v[j][2] * v[j][2] + v[j][3] * v[j][3]); }
        const float rstd = 1.f / sqrtf(wave_sum(s2) * (1.f / D) + LN_EPS);
        bf16_t* xb = XB + (size_t)row * D + 4 * lane;
#pragma unroll
        for (int j = 0; j < 4; ++j) { const f32x4 o = v[j] * rstd * gv[j] + bv[j]; *(f32x4*)(xr + 256 * j) = o; u32x2 w; w.x = pk2(o[0], o[1]); w.y = pk2(o[2], o[3]); *(u32x2*)(xb + 256 * j) = w; }
    }
}

constexpr int LDS_BYTES = 147456;
__global__ void __launch_bounds__(NTHREADS, 2) fwd_megakernel(Params P) {
    extern __shared__ __attribute__((aligned(16))) unsigned char lds_raw[];
    cg::grid_group grid = cg::this_grid();
    LAS unsigned char* lds = (LAS unsigned char*)lds_raw;
    const int G = gridDim.x, bx = blockIdx.x;
    const int vcu = (G % 8 == 0) ? (bx % 8) * (G / 8) + bx / 8 : bx;
    const int NGW = G * NWAVES;
#define PHASE_IDS int tid = threadIdx.x; asm volatile("" : "+v"(tid)); const int lane = tid & 63, wave = __builtin_amdgcn_readfirstlane(tid >> 6), gw = vcu * NWAVES + wave; (void)lane; (void)gw;
#define PHASE_GTID const size_t gtid = (size_t)bx * NTHREADS + tid, nthr = (size_t)G * NTHREADS;
    unsigned char* ws = P.ws;
    float* cosT = (float*)(ws + WS_COS); float* sinT = (float*)(ws + WS_SIN); float* biasT = (float*)(ws + WS_BIAST);
    float* rstdq = (float*)(ws + WS_RSTDQ); float* rstdkv = (float*)(ws + WS_RSTDKV);
    float* lf = (float*)(ws + WS_LF); float* ck = (float*)(ws + WS_CK); bf16_t* KR = (bf16_t*)(ws + WS_KR);
    bf16_t* WB = (bf16_t*)(ws + WS_W); bf16_t* PB = (bf16_t*)(ws + WS_PB);
    bf16_t* XBUF[2] = {(bf16_t*)(ws + WS_XB0), (bf16_t*)(ws + WS_XB1)};
    unsigned char* ACT = ws + WS_ACT;
    float* R = P.out;

    {
        PHASE_IDS PHASE_GTID
        LAS float* scr = (LAS float*)(lds + wave * 16384);
        for (int j = 0; j < 2; ++j) {
            bf16_t* we = WB + W_EVEN0 + j * WE_SZ;
            prep_w(P.ev_w_in + (size_t)j * D * EIN, D, EIN, EIN, EINP, we + WE_IN, nullptr, scr, gw, NGW, lane);
            prep_w(P.ev_w_uq + (size_t)j * 384 * 768, 384, 768, 768, 768, we + WE_UQ, P.ev_q_norm + j * 384, scr, gw, NGW, lane);
            prep_w(P.ev_w_ukv + (size_t)j * 256 * 1024, 256, 1024, 1024, 1024, we + WE_UKV, P.ev_kv_norm + j * 256, scr, gw, NGW, lane);
            prep_w(P.ev_w_out + (size_t)j * D * D, D, D, D, D, we + WE_OUT, nullptr, scr, gw, NGW, lane);
            bf16_t* wo = WB + W_ODD0 + j * WO_SZ;
            prep_w(P.od_w_in + (size_t)j * D * OIN, D, OIN, OIN, OINP, wo + WO_IN, nullptr, scr, gw, NGW, lane);
            prep_w(P.od_w_out + (size_t)j * D * D, D, D, D, D, wo + WO_OUT, nullptr, scr, gw, NGW, lane);
        }
        for (int i = 0; i < DEPTH; ++i) {
            bf16_t* wc = WB + W_COM0 + i * WC_SZ;
            prep_w(P.w_up + (size_t)i * D * FF, D, FF, FF, FF, wc + WC_UP, nullptr, scr, gw, NGW, lane);
            prep_w(P.w_down + (size_t)i * FF * D, FF, D, D, D, wc + WC_DOWN, nullptr, scr, gw, NGW, lane);
            prep_w(P.ple_w_gate + (size_t)i * D * D, D, D, D, D, wc + WC_G, nullptr, scr, gw, NGW, lane);
            prep_w(P.ple_w_proj + (size_t)i * DPLE * D, DPLE, D, D, D, wc + WC_P, nullptr, scr, gw, NGW, lane);
        }
        cvt_bf16(P.x, XBUF[0], (size_t)M * D / 8, gtid, nthr);
        if (gtid < (size_t)SEQ * 16) { const int pos = (int)gtid >> 4, i = (int)gtid & 15;
            const float inv = 1.0f / powf(10000.0f, (float)i * (1.0f / 16.0f)); const float ang = (float)pos * inv;
            cosT[gtid] = cosf(ang); sinT[gtid] = sinf(ang); }
        if (gtid < 8 * 128) { const int h = (int)gtid >> 7, d = (int)gtid & 127; int bkt;
            if (d < 16) bkt = d; else { const float t = logf((float)d / 16.0f) / 2.0794415416798357f * 16.0f; bkt = 16 + (int)t; if (bkt > 31) bkt = 31; }
            biasT[gtid] = P.rel_bias[bkt * 8 + h] * LOG2E; }
    }
    grid.sync();

    for (int layer = 0; layer < DEPTH; ++layer) {
        const int j = layer >> 1; const bool even = (layer & 1) == 0;
        bf16_t* XB = XBUF[layer & 1]; bf16_t* XN = XBUF[(layer + 1) & 1];
        bf16_t* wcom = WB + W_COM0 + layer * WC_SZ;
        const bf16_t* w_out_t;
        if (even) {
            bf16_t* we = WB + W_EVEN0 + j * WE_SZ; w_out_t = we + WE_OUT;
            bf16_t* H = (bf16_t*)(ACT + ACT_H); bf16_t* Q = (bf16_t*)(ACT + ACT_Q); bf16_t* KV = (bf16_t*)(ACT + ACT_KV);
            { pg8::Gemm g{XB, we + WE_IN, M, EINP, D, D}; pg8::StaticOrder S; S.init(M, EINP, G, bx);
              pg8::EpiBf16<0, false> E{H, EINP, nullptr, nullptr}; pg8::gemm_phase<pg8::EpiBf16<0, false>, true>(lds, g, S, E); }
            grid.sync();
            { PHASE_IDS
            for (int row = gw; row < M; row += NGW) {
                const bf16_t* hr = H + (size_t)row * EINP;
                u32x4 a = {0u, 0u, 0u, 0u}, b = {0u, 0u, 0u, 0u};
                if (lane < 48) a = *(const u32x4*)(hr + 8 * lane);
                if (lane < 36) b = *(const u32x4*)(hr + 384 + 8 * lane);
                float av[8] = {bflo(a.x), bfhi(a.x), bflo(a.y), bfhi(a.y), bflo(a.z), bfhi(a.z), bflo(a.w), bfhi(a.w)};
                float bv[8] = {bflo(b.x), bfhi(b.x), bflo(b.y), bfhi(b.y), bflo(b.z), bfhi(b.z), bflo(b.w), bfhi(b.w)};
                float sa = 0.f, sb = 0.f;
#pragma unroll
                for (int e = 0; e < 8; ++e) { sa += av[e] * av[e]; sb += bv[e] * bv[e]; }
                if (lane >= 32) sb = 0.f;
                sa = wave_sum(sa); sb = wave_sum(sb);
                if (lane == 0) { rstdq[row] = 1.f / sqrtf(sa * (1.f / 384.f) + LN_EPS); rstdkv[row] = 1.f / sqrtf(sb * (1.f / 256.f) + LN_EPS); }
                float pv[8];
#pragma unroll
                for (int e = 0; e < 8; ++e) pv[e] = __shfl_xor(bv[e], 2);
                if (lane >= 32 && lane < 36) { const int a4 = lane - 32, pos = row & (SEQ - 1); const float* ct = cosT + pos * 16 + 8 * (a4 & 1); const float* st = sinT + pos * 16 + 8 * (a4 & 1);
                    float o[8];
#pragma unroll
                    for (int e = 0; e < 8; ++e) o[e] = (a4 < 2) ? bv[e] * ct[e] - pv[e] * st[e] : bv[e] * ct[e] + pv[e] * st[e];
                    u32x4 w; w.x = pk2(o[0], o[1]); w.y = pk2(o[2], o[3]); w.z = pk2(o[4], o[5]); w.w = pk2(o[6], o[7]);
                    *(u32x4*)(KR + (size_t)row * 32 + 8 * a4) = w; }
            } }
            grid.sync();
            { pg8::Gemm g{H, we + WE_UQ, M, 768, 384, EINP}; pg8::StaticOrder S; S.init(M, 768, G, bx);
              pg8::EpiScale<true> E{Q, 768, rstdq, cosT, sinT}; pg8::gemm_phase<pg8::EpiScale<true>, true>(lds, g, S, E); }
            { pg8::Gemm g{H + 384, we + WE_UKV, M, 1024, 256, EINP}; pg8::StaticOrder S; S.init(M, 1024, G, bx);
              pg8::EpiScale<false> E{KV, 1024, rstdkv, cosT, sinT}; pg8::gemm_phase<pg8::EpiScale<false>, true>(lds, g, S, E); }
            grid.sync();
            for (int bh = vcu; bh < NBATCH * 8; bh += G) { const int b = bh >> 3, h = bh & 7; const size_t t0 = (size_t)b * SEQ;
                att::Tens T; T.Q = Q + t0 * 768 + h * 96; T.qpitch = 768; T.KA = KV + t0 * 1024 + h * 128; T.kpitch = 1024; T.KB = KR + t0 * 32;
                T.V = KV + t0 * 1024 + h * 128 + 64; T.vpitch = 1024; T.kbias = nullptr; T.O = XN + t0 * D + h * 64; T.scale_l2 = 0.10206207261596577f * LOG2E; T.sink_l2 = 0.f;
                for (int qb = 0; qb < 8; ++qb) att::unit<0>(lds, T, qb); }
            for (int bh = vcu; bh < NBATCH * 8; bh += G) { const int b = bh >> 3, h = bh & 7, kvh = h >> 2; const size_t t0 = (size_t)b * SEQ;
                att::Tens T; T.Q = H + t0 * EINP + 672 + h * 64; T.qpitch = EINP; T.KA = H + t0 * EINP + 1184 + kvh * 64; T.kpitch = EINP; T.KB = nullptr;
                T.V = H + t0 * EINP + 1312 + kvh * 64; T.vpitch = EINP; T.kbias = biasT + h * 128; T.O = XN + t0 * D + 512 + h * 64; T.scale_l2 = 0.125f * LOG2E; T.sink_l2 = P.ev_sinks[j * 8 + h] * LOG2E;
                for (int qb = 0; qb < 8; ++qb) att::unit<2>(lds, T, qb); }
            grid.sync();
        } else {
            bf16_t* wo = WB + W_ODD0 + j * WO_SZ; w_out_t = wo + WO_OUT;
            bf16_t* H = (bf16_t*)(ACT + ACT_H);
            { pg8::Gemm g{XB, wo + WO_IN, M, OINP, D, D}; pg8::StaticOrder S; S.init(M, OINP, G, bx);
              pg8::EpiBf16<0, true> E{H, OINP, lf, P.od_b_f + j * 16}; pg8::gemm_phase<pg8::EpiBf16<0, true>, true>(lds, g, S, E); }
            grid.sync();
            { PHASE_IDS
            for (int sq = gw; sq < NBATCH * 16; sq += NGW) { const int b = sq >> 4, h = sq & 15;
                const float* src = lf + ((size_t)b * SEQ + 32 * lane) * 16 + h; float v[32]; float run = 0.f;
#pragma unroll
                for (int i = 0; i < 32; ++i) { run += src[i * 16]; v[i] = run; }
                float incl = run;
#pragma unroll
                for (int o = 1; o < 64; o <<= 1) { const float t = __shfl_up(incl, o); if (lane >= o) incl += t; }
                const float excl = incl - run; float* dst = ck + (size_t)sq * SEQ + 32 * lane;
#pragma unroll
                for (int i = 0; i < 32; i += 4) { f32x4 o4; o4[0] = -(v[i] + excl) * LOG2E; o4[1] = -(v[i + 1] + excl) * LOG2E; o4[2] = -(v[i + 2] + excl) * LOG2E; o4[3] = -(v[i + 3] + excl) * LOG2E; *(f32x4*)(dst + i) = o4; }
            } }
            grid.sync();
            for (int bh = vcu; bh < NBATCH * 16; bh += G) { const int b = bh >> 4, h = bh & 15; const size_t t0 = (size_t)b * SEQ;
                att::Tens T; T.Q = H + t0 * OINP + h * 64; T.qpitch = OINP; T.KA = H + t0 * OINP + 1024 + h * 64; T.kpitch = OINP; T.KB = nullptr;
                T.V = H + t0 * OINP + 2048 + h * 64; T.vpitch = OINP; T.kbias = ck + (size_t)bh * SEQ; T.O = XN + t0 * D + h * 64; T.scale_l2 = 0.125f * LOG2E; T.sink_l2 = 0.f;
                for (int qb = 0; qb < 8; ++qb) att::unit<1>(lds, T, qb); }
            grid.sync();
        }
        { pg8::Gemm g{XN, w_out_t, M, D, D, D}; pg8::StaticOrder S; S.init(M, D, G, bx);
          pg8::EpiResid E{layer == 0 ? P.x : R, R}; pg8::gemm_phase<pg8::EpiResid, true>(lds, g, S, E); }
        grid.sync();
        { PHASE_IDS PHASE_GTID
        ln_pass(R, XB, P.ln1_g + layer * D, P.ln1_b + layer * D, gw, NGW, lane);
        cvt_bf16(P.p + (size_t)layer * M * DPLE, PB, (size_t)M * DPLE / 8, gtid, nthr); }
        grid.sync();
        { pg8::Gemm g{XB, wcom + WC_UP, M, FF, D, D}; pg8::StaticOrder S; S.init(M, FF, G, bx);
          pg8::EpiBf16<1, false> E{(bf16_t*)ACT, FF, nullptr, nullptr}; pg8::gemm_phase<pg8::EpiBf16<1, false>, true>(lds, g, S, E); }
        { pg8::Gemm g{PB, wcom + WC_P, M, D, DPLE, DPLE}; pg8::StaticOrder S; S.init(M, D, G, bx);
          pg8::EpiBf16<0, false> E{XN, D, nullptr, nullptr}; pg8::gemm_phase<pg8::EpiBf16<0, false>, true>(lds, g, S, E); }
        grid.sync();
        { pg8::Gemm g{(const bf16_t*)ACT, wcom + WC_DOWN, M, D, FF, FF}; pg8::StaticOrder S; S.init(M, D, G, bx);
          pg8::EpiResid E{R, R}; pg8::gemm_phase<pg8::EpiResid, true>(lds, g, S, E); }
        grid.sync();
        { PHASE_IDS
        ln_pass(R, XB, P.ln2_g + layer * D, P.ln2_b + layer * D, gw, NGW, lane); }
        grid.sync();
        { pg8::Gemm g{XB, wcom + WC_G, M, D, D, D}; pg8::StaticOrder S; S.init(M, D, G, bx);
          pg8::EpiGate E{R, XN, P.ple_b_gate + layer * D}; pg8::gemm_phase<pg8::EpiGate, true>(lds, g, S, E); }
        grid.sync();
    }
}

extern "C" void kernel_launch(void* const* d_in, const int* in_sizes, int n_in, void* d_out, int out_size, void* d_ws, size_t ws_size, hipStream_t stream) {
    static int grid = 0;
    if (grid == 0) {
        if (n_in != 22 || out_size != M * D || ws_size < WS_END) { fprintf(stderr, "kernel_launch: unexpected sizes n_in %d out %d ws %zu (need %zu)\n", n_in, out_size, ws_size, (size_t)WS_END); grid = -1; return; }
        int dev = 0, cus = 0, per_cu = 0;
        hipGetDevice(&dev); hipDeviceGetAttribute(&cus, hipDeviceAttributeMultiprocessorCount, dev);
        if (hipFuncSetAttribute((const void*)fwd_megakernel, hipFuncAttributeMaxDynamicSharedMemorySize, LDS_BYTES) != hipSuccess) { fprintf(stderr, "kernel_launch: hipFuncSetAttribute failed\n"); grid = -1; return; }
        if (hipOccupancyMaxActiveBlocksPerMultiprocessor(&per_cu, (const void*)fwd_megakernel, NTHREADS, LDS_BYTES) != hipSuccess || per_cu < 1) { fprintf(stderr, "kernel_launch: occupancy query says %d\n", per_cu); per_cu = 1; }
        (void)hipGetLastError();
        grid = cus * 1;
    }
    if (grid < 0) return;
    Params p{};
    const float** f = (const float**)&p;
    for (int i = 0; i < 22; ++i) f[i] = (const float*)d_in[i];
    p.out = (float*)d_out; p.ws = (unsigned char*)d_ws;
    void* args[] = {&p};
    hipError_t e = hipLaunchCooperativeKernel((const void*)fwd_megakernel, dim3(grid), dim3(NTHREADS), args, LDS_BYTES, stream);
    if (e != hipSuccess) fprintf(stderr, "cooperative launch failed: %s (grid %d)\n", hipGetErrorString(e), grid);
}
```

```cpp
#include <hip/hip_runtime.h>
#include <hip/hip_cooperative_groups.h>
#include <cstdio>
#include <cstdint>
namespace cg = cooperative_groups;
#ifndef PROBE
#define PROBE 0
#endif
#define PROBE_CAT_A 2
#define PROBE_CAT_B 2

#define LAS __attribute__((address_space(3)))
typedef unsigned short bf16_t;
typedef short bf16x8 __attribute__((ext_vector_type(8)));
typedef float f32x4 __attribute__((ext_vector_type(4)));
typedef float f32x16 __attribute__((ext_vector_type(16)));
typedef unsigned u32x4 __attribute__((ext_vector_type(4)));
typedef unsigned u32x2 __attribute__((ext_vector_type(2)));
typedef float f32x2_t __attribute__((ext_vector_type(2)));
typedef __bf16 bf16x2_t __attribute__((ext_vector_type(2)));

constexpr int M = 65536, SEQ = 2048, NBATCH = 32, D = 1024, FF = 4096, DPLE = 256, DEPTH = 4;
constexpr int EIN = 1440, EINP = 1536, OIN = 3088, OINP = 3328;
constexpr float ALPHA = 1.6817928305074290f;
constexpr float LN_EPS = 1e-5f;
constexpr float LOG2E = 1.4426950408889634f;
constexpr int NTHREADS = 512, NWAVES = 8;

constexpr size_t MiB = 1u << 20;
constexpr size_t WS_COS = 0, WS_SIN = 128 * 1024, WS_BIAST = 256 * 1024;
constexpr size_t WS_RSTDQ = 1 * MiB, WS_RSTDKV = 1 * MiB + 256 * 1024;
constexpr size_t WS_VEC = 1 * MiB + 512 * 1024, VEC_LAYER = 10240, VECI_BYTES = 4 * VEC_LAYER * 8;
constexpr size_t WS_LF = 2 * MiB, WS_CK = 6 * MiB, WS_KR = 10 * MiB, WS_W = 14 * MiB;
constexpr size_t WS_PB = 120 * MiB, WS_XB0 = 152 * MiB, WS_XB1 = 280 * MiB, WS_ACT = 408 * MiB, WS_ST1 = 920 * MiB, WS_ST2 = 921 * MiB, WS_VECI = 922 * MiB, WS_BAR = 922 * MiB + 512 * 1024, WS_ZERO_BYTES = 512 * 1024 + 16384, WS_SQ = 923 * MiB, WS_END = 925 * MiB;
constexpr size_t WE_IN = 0, WE_UQ = (size_t)EINP * D, WE_UKV = WE_UQ + 768 * 384, WE_OUT = WE_UKV + 1024 * 256, WE_SZ = WE_OUT + (size_t)D * D;
constexpr size_t WO_IN = 0, WO_OUT = (size_t)OINP * D, WO_SZ = WO_OUT + (size_t)D * D;
constexpr size_t WC_UP = 0, WC_DOWN = (size_t)FF * D, WC_G = 2 * (size_t)FF * D, WC_P = WC_G + (size_t)D * D, WC_SZ = WC_P + (size_t)D * DPLE;
constexpr size_t W_EVEN0 = 0, W_ODD0 = 2 * WE_SZ, W_COM0 = W_ODD0 + 2 * WO_SZ, W_TOTAL = W_COM0 + 4 * WC_SZ;
static_assert(WS_W + W_TOTAL * 2 <= WS_PB, "weights fit");
constexpr size_t ACT_H = 0, ACT_Q = 192 * MiB, ACT_KV = 288 * MiB;

__device__ __forceinline__ unsigned pk2(float lo, float hi) { f32x2_t v = {lo, hi}; bf16x2_t b = __builtin_convertvector(v, bf16x2_t); return __builtin_bit_cast(unsigned, b); }
__device__ __forceinline__ float bf2f(unsigned short u) { return __uint_as_float(((unsigned)u) << 16); }
__device__ __forceinline__ float bflo(unsigned u) { return __uint_as_float(u << 16); }
__device__ __forceinline__ float bfhi(unsigned u) { return __uint_as_float(u & 0xffff0000u); }
#define LDS_WAIT() asm volatile("s_waitcnt lgkmcnt(0)" ::: "memory")
__device__ __forceinline__ float bperm(float v, int srclane) { return __builtin_bit_cast(float, __builtin_amdgcn_ds_bpermute((srclane & 63) << 2, __builtin_bit_cast(int, v))); }
__device__ __forceinline__ float wave_sum(float v, int lane) {
#pragma unroll
    for (int o = 1; o < 64; o <<= 1) v += bperm(v, lane ^ o);
    return v;
}

__device__ __forceinline__ int lane_opq() { unsigned m = ~0u; asm volatile("" : "+s"(m)); return (int)__builtin_amdgcn_mbcnt_hi(m, __builtin_amdgcn_mbcnt_lo(m, 0u)); }
__device__ __forceinline__ float shx(float v, int lane, int mask) { return __builtin_bit_cast(float, __builtin_amdgcn_ds_bpermute(((lane ^ mask) & 63) << 2, __builtin_bit_cast(int, v))); }
template <class T> __device__ __forceinline__ T ldg(const void* base, unsigned byteoff) { return *(const T*)((const char*)base + byteoff); }
template <class T> __device__ __forceinline__ void stg(void* base, unsigned byteoff, T v) { *(T*)((char*)base + byteoff) = v; }

namespace pg8 {
constexpr int BM = 256, BK = 64, HALF = 128, HTB = HALF * BK * 2, STAGE_BYTES = 8 * HTB, NXCD = 8, WGM = 8;
__device__ __forceinline__ int lds_byte(int r, int c) { const int st = (r >> 4) * 2 + (c >> 5), rr = r & 15, cc = c & 31, ob = rr * 64 + cc * 2; return st * 1024 + (ob ^ (((ob >> 9) & 1) << 5)); }
__device__ __forceinline__ void stage_rc(int b, int& R, int& C) { const int st = b / 1024, sb = b % 1024, swz = sb ^ (((sb >> 9) & 1) << 5); R = (st >> 1) * 16 + swz / 64; C = (st & 1) * 32 + (swz % 64) / 2; }
__device__ __forceinline__ int perm32(int rho) { const int n = rho >> 4, i = rho & 15; return 8 * (i >> 2) + 4 * n + (i & 3); }

struct Unit { int pm, pn; };
struct Gemm { const bf16_t* A; const bf16_t* Bt; int M, N, K, lda, wave; };

struct StaticOrder {
    int nM, nN, nwg, G, c;
    __device__ void init(int M_, int N_, int G_, int c_) { nM = M_ / BM; nN = N_ / BM; nwg = nM * nN; G = G_; c = c_; }
    __device__ bool next(int i, Unit& u) const {
        const long L = (long)i * G + c; if (L >= nwg) return false;
        int wgid = (int)L; { const int q = nwg / NXCD, r = nwg % NXCD, xcd = wgid % NXCD, off = wgid / NXCD; wgid = (xcd < r ? xcd * (q + 1) : r * (q + 1) + (xcd - r) * q) + off; }
        const int nig = WGM * nN, gid = wgid / nig, fm = gid * WGM, gsz = (nM - fm) < WGM ? (nM - fm) : WGM;
        u.pm = fm + ((wgid % nig) % gsz); u.pn = (wgid % nig) / gsz; return true;
    }
};


constexpr float FIX_SCALE = 4294967296.0f; constexpr double FIX_INV = 1.0 / 4294967296.0;
typedef long long i64x2 __attribute__((ext_vector_type(2)));
__device__ __forceinline__ void fix_add(long long* p, float v) { atomicAdd((unsigned long long*)p, (unsigned long long)__float2ll_rn(v * FIX_SCALE)); }
struct EpiEvenIn {
    static constexpr bool PERM = true;
    bf16_t* O; long long* sq; bf16_t* kr; const float* cosT; const float* sinT; float qsc;
    __device__ __forceinline__ void operator()(const f32x4 (&acc)[2][2][4][2], const Unit& u, int wr, int wc, int fr_, int fq_) const {
        int t_ = lane_opq(); const int fr = t_ & 15, fq = (t_ >> 4) & 3; (void)fr_; (void)fq_;
        const int row0 = u.pm * BM + wr * 64 + fr, col0 = u.pn * BM + wc * 32 + 8 * fq;
#pragma unroll
        for (int bj = 0; bj < 2; ++bj) { const int grp = (u.pn * BM + bj * HALF + wc * 32) >> 5;
            const float f = (grp >= 21 && grp < 37) ? qsc : 1.f;
#pragma unroll
            for (int ai = 0; ai < 2; ++ai)
#pragma unroll
                for (int m = 0; m < 4; ++m) { const int row = row0 + ai * HALF + m * 16; f32x4 v0 = acc[ai][bj][m][0], v1 = acc[ai][bj][m][1];
                    if (grp < 20) {
                        float q = ((v0[0] * v0[0] + v0[1] * v0[1]) + (v0[2] * v0[2] + v0[3] * v0[3])) + ((v1[0] * v1[0] + v1[1] * v1[1]) + (v1[2] * v1[2] + v1[3] * v1[3]));
                        q += shx(q, t_, 16); q += shx(q, t_, 32);
                        if (fq == 0) fix_add(sq + 2 * (size_t)row + (grp < 12 ? 0 : 1), q);
                    } else if (grp == 20) {
                        f32x4 p0, p1;
#pragma unroll
                        for (int e = 0; e < 4; ++e) { p0[e] = shx(v0[e], t_, 32); p1[e] = shx(v1[e], t_, 32); }
                        const int pos = row & (SEQ - 1); const float* ct = cosT + pos * 16 + 8 * (fq & 1); const float* st = sinT + pos * 16 + 8 * (fq & 1);
                        const f32x4 c0 = *(const f32x4*)ct, c1 = *(const f32x4*)(ct + 4), s0 = *(const f32x4*)st, s1 = *(const f32x4*)(st + 4);
                        const float sg = (fq < 2) ? -1.f : 1.f; const f32x4 r0 = v0 * c0 + p0 * (s0 * sg), r1 = v1 * c1 + p1 * (s1 * sg);
                        u32x4 w; w.x = pk2(r0[0], r0[1]); w.y = pk2(r0[2], r0[3]); w.z = pk2(r1[0], r1[1]); w.w = pk2(r1[2], r1[3]);
                        *(u32x4*)(kr + (size_t)row * 32 + 8 * fq) = w;
                    }
                    v0 = v0 * f; v1 = v1 * f;
                    u32x4 w; w.x = pk2(v0[0], v0[1]); w.y = pk2(v0[2], v0[3]); w.z = pk2(v1[0], v1[1]); w.w = pk2(v1[2], v1[3]);
                    *(u32x4*)(O + (size_t)row * EINP + col0 + bj * HALF) = w;
                    if (m & 1) asm volatile("" ::: "memory"); } }
    }
};
template <int ACT  , bool ODDF> struct EpiBf16 {
    static constexpr bool PERM = true;
    bf16_t* O; int ldc; float* lf; const float* bf; int sc_lo, sc_hi; float sc;
    __device__ __forceinline__ void operator()(const f32x4 (&acc)[2][2][4][2], const Unit& u, int wr, int wc, int fr_, int fq_) const {
        int t_ = lane_opq(); const int fr = t_ & 15, fq = (t_ >> 4) & 3; (void)fr_; (void)fq_;
        const int row0 = u.pm * BM + wr * 64 + fr;
        if (ODDF && u.pn == 12) {
            if (wc == 0 && fq < 2) {
                const f32x4 b0 = *(const f32x4*)(bf + 8 * fq), b1 = *(const f32x4*)(bf + 8 * fq + 4);
#pragma unroll
                for (int ai = 0; ai < 2; ++ai)
#pragma unroll
                    for (int m = 0; m < 4; ++m) {
                        const f32x4 z0 = acc[ai][0][m][0] + b0, z1 = acc[ai][0][m][1] + b1; f32x4 o0, o1;
#pragma unroll
                        for (int e = 0; e < 4; ++e) { o0[e] = fminf(z0[e], 0.f) - log1pf(expf(-fabsf(z0[e]))); o1[e] = fminf(z1[e], 0.f) - log1pf(expf(-fabsf(z1[e]))); }
                        float* p = lf + (size_t)(row0 + ai * HALF + m * 16) * 16 + 8 * fq;
                        *(f32x4*)p = o0; *(f32x4*)(p + 4) = o1;
                    }
            }
            return;
        }
        const int col0 = u.pn * BM + wc * 32 + 8 * fq;
#pragma unroll
        for (int ai = 0; ai < 2; ++ai)
#pragma unroll
            for (int m = 0; m < 4; ++m) { bf16_t* rowp = O + (size_t)(row0 + ai * HALF + m * 16) * ldc + col0;
#pragma unroll
                for (int bj = 0; bj < 2; ++bj) { f32x4 v0 = acc[ai][bj][m][0], v1 = acc[ai][bj][m][1];
                    if (ACT == 0) { const int grp = (u.pn * BM + bj * HALF + wc * 32) >> 5; const float f = (grp >= sc_lo && grp < sc_hi) ? sc : 1.f; v0 = v0 * f; v1 = v1 * f; }
                    if (ACT == 1) {
#pragma unroll
                        for (int e = 0; e < 4; ++e) { const float a = fmaxf(v0[e], 0.f), b = fmaxf(v1[e], 0.f); v0[e] = a * a; v1[e] = b * b; } }
                    u32x4 w; w.x = pk2(v0[0], v0[1]); w.y = pk2(v0[2], v0[3]); w.z = pk2(v1[0], v1[1]); w.w = pk2(v1[2], v1[3]);
                    *(u32x4*)(rowp + bj * HALF) = w; } }
    }
};
template <bool ROPE> struct EpiScale {
    static constexpr bool PERM = true;
    bf16_t* O; int ldc; const long long* sq; float invk; const float* cosT; const float* sinT; float qs;
    __device__ __forceinline__ void operator()(const f32x4 (&acc)[2][2][4][2], const Unit& u, int wr, int wc, int fr_, int fq_) const {
        int t_ = lane_opq(); const int fr = t_ & 15, fq = (t_ >> 4) & 3; (void)fr_; (void)fq_;
        const int row0 = u.pm * BM + wr * 64 + fr;
        const int col0 = u.pn * BM + wc * 32 + 8 * fq;
        float rsv[2][4];
        { long long sv[2][4];
#pragma unroll
          for (int ai = 0; ai < 2; ++ai)
#pragma unroll
              for (int m = 0; m < 4; ++m) sv[ai][m] = sq[2 * (size_t)(row0 + ai * HALF + m * 16)];
#pragma unroll
          for (int ai = 0; ai < 2; ++ai)
#pragma unroll
              for (int m = 0; m < 4; ++m) rsv[ai][m] = qs / sqrtf((float)((double)sv[ai][m] * FIX_INV) * invk + LN_EPS); }
#pragma unroll
        for (int ai = 0; ai < 2; ++ai)
#pragma unroll
            for (int m = 0; m < 4; ++m) { const int row = row0 + ai * HALF + m * 16; const float rs = rsv[ai][m]; bf16_t* rowp = O + (size_t)row * ldc + col0;
#pragma unroll
                for (int bj = 0; bj < 2; ++bj) { f32x4 v0 = acc[ai][bj][m][0] * rs, v1 = acc[ai][bj][m][1] * rs;
                    if (ROPE) {
                        const int grp = (u.pn * BM + bj * HALF + wc * 32) >> 5;
                        if (grp % 3 == 2) {
                            f32x4 p0, p1;
#pragma unroll
                            for (int e = 0; e < 4; ++e) { p0[e] = shx(v0[e], t_, 32); p1[e] = shx(v1[e], t_, 32); }
                            const int pos = row & (SEQ - 1); const float* ct = cosT + pos * 16 + 8 * (fq & 1); const float* st = sinT + pos * 16 + 8 * (fq & 1);
                            const f32x4 c0 = *(const f32x4*)ct, c1 = *(const f32x4*)(ct + 4), s0 = *(const f32x4*)st, s1 = *(const f32x4*)(st + 4);
                            const float sg = (fq < 2) ? -1.f : 1.f; v0 = v0 * c0 + p0 * (s0 * sg); v1 = v1 * c1 + p1 * (s1 * sg);
                        }
                    }
                    u32x4 w; w.x = pk2(v0[0], v0[1]); w.y = pk2(v0[2], v0[3]); w.z = pk2(v1[0], v1[1]); w.w = pk2(v1[2], v1[3]);
                    *(u32x4*)(rowp + bj * HALF) = w; }
                if (m & 1) asm volatile("" ::: "memory"); }
    }
};
struct EpiResid {
    static constexpr bool PERM = false;
    const float* xres; float* out;
    __device__ __forceinline__ void operator()(const f32x4 (&acc)[2][2][4][2], const Unit& u, int wr, int wc, int fr_, int fq_) const {
        int t_ = lane_opq(); const int fr = t_ & 15, fq = (t_ >> 4) & 3; (void)fr_; (void)fq_;
        const int col0 = u.pn * BM + wc * 32 + 4 * fq;
#pragma unroll
        for (int ai = 0; ai < 2; ++ai)
#pragma unroll
            for (int m = 0; m < 4; ++m) { const size_t off = (size_t)(u.pm * BM + ai * HALF + wr * 64 + m * 16 + fr) * D + col0;
#pragma unroll
                for (int bj = 0; bj < 2; ++bj)
#pragma unroll
                    for (int n = 0; n < 2; ++n) { const f32x4 xs = *(const f32x4*)(xres + off + bj * HALF + n * 16); *(f32x4*)(out + off + bj * HALF + n * 16) = xs * ALPHA + acc[ai][bj][m][n]; } }
    }
};
struct EpiGate {
    static constexpr bool PERM = false;
    float* x; bf16_t* ppx; const float* bg;
    __device__ __forceinline__ void operator()(const f32x4 (&acc)[2][2][4][2], const Unit& u, int wr, int wc, int fr_, int fq_) const {
        int t_ = lane_opq(); const int fr = t_ & 15, fq = (t_ >> 4) & 3; (void)fr_; (void)fq_;
        const int col0 = u.pn * BM + wc * 32 + 4 * fq;
#pragma unroll
        for (int bj = 0; bj < 2; ++bj)
#pragma unroll
            for (int n = 0; n < 2; ++n) { const f32x4 bv = *(const f32x4*)(bg + col0 + bj * HALF + n * 16);
#pragma unroll
                for (int ai = 0; ai < 2; ++ai)
#pragma unroll
                    for (int m = 0; m < 4; ++m) { const size_t off = (size_t)(u.pm * BM + ai * HALF + wr * 64 + m * 16 + fr) * D + col0 + bj * HALF + n * 16;
                        const f32x4 xs = *(const f32x4*)(x + off); const u32x2 pw = *(const u32x2*)(ppx + off);
                        const f32x4 z = acc[ai][bj][m][n] + bv; f32x4 o;
                        o[0] = xs[0] + bflo(pw.x) / (1.f + __expf(-z[0])); o[1] = xs[1] + bfhi(pw.x) / (1.f + __expf(-z[1]));
                        o[2] = xs[2] + bflo(pw.y) / (1.f + __expf(-z[2])); o[3] = xs[3] + bfhi(pw.y) / (1.f + __expf(-z[3]));
                        *(f32x4*)(x + off) = o; u32x2 w; w.x = pk2(o[0], o[1]); w.y = pk2(o[2], o[3]); *(u32x2*)(ppx + off) = w;
                        if (m & 1) asm volatile("" ::: "memory"); } }
    }
};


__device__ __forceinline__ void row_stats(const long long* st, int row, float& mu, float& rs) {
    const i64x2 v = *(const i64x2*)(st + 2 * (size_t)row); const float s1 = (float)((double)v.x * FIX_INV), s2 = (float)((double)v.y * FIX_INV);
    mu = s1 * (1.f / D); const float var = fmaxf(s2 * (1.f / D) - mu * mu, 0.f); rs = 1.f / sqrtf(var + LN_EPS);
}
__device__ __forceinline__ void unpack8(const u32x4 w, f32x4& lo, f32x4& hi) { lo[0] = bflo(w.x); lo[1] = bfhi(w.x); lo[2] = bflo(w.y); lo[3] = bfhi(w.y); hi[0] = bflo(w.z); hi[1] = bfhi(w.z); hi[2] = bflo(w.w); hi[3] = bfhi(w.w); }
template <bool LNIN> struct EpiResidStats {
    static constexpr bool PERM = true;
    bf16_t* yb; long long* st_out; const long long* st_in; const float* g; const float* b;
    __device__ __forceinline__ void operator()(const f32x4 (&acc)[2][2][4][2], const Unit& u, int wr, int wc, int fr_, int fq_) const {
        int t_ = lane_opq(); const int fr = t_ & 15, fq = (t_ >> 4) & 3; (void)fr_; (void)fq_;
        const int col0 = u.pn * BM + wc * 32 + 8 * fq, rowb = u.pm * BM + wr * 64 + fr;
        float sm[2][4], sq[2][4], mu[2][4], rs[2][4];
#pragma unroll
        for (int ai = 0; ai < 2; ++ai)
#pragma unroll
            for (int m = 0; m < 4; ++m) { sm[ai][m] = 0.f; sq[ai][m] = 0.f; mu[ai][m] = 0.f; rs[ai][m] = 1.f; if (LNIN) row_stats(st_in, rowb + ai * HALF + m * 16, mu[ai][m], rs[ai][m]); }
#pragma unroll
        for (int bj = 0; bj < 2; ++bj) { const int c = col0 + bj * HALF;
            f32x4 g0 = {1.f, 1.f, 1.f, 1.f}, g1 = g0, b0 = {0.f, 0.f, 0.f, 0.f}, b1 = b0;
            if (LNIN) { g0 = *(const f32x4*)(g + c); g1 = *(const f32x4*)(g + c + 4); b0 = *(const f32x4*)(b + c); b1 = *(const f32x4*)(b + c + 4); }
            u32x4 ld[2][4];
#pragma unroll
            for (int ai = 0; ai < 2; ++ai)
#pragma unroll
                for (int m = 0; m < 4; ++m) ld[ai][m] = ldg<u32x4>(yb, ((unsigned)(rowb + ai * HALF + m * 16) * D + (unsigned)c) * 2u);
#pragma unroll
            for (int ai = 0; ai < 2; ++ai)
#pragma unroll
                for (int m = 0; m < 4; ++m) { const unsigned off2 = ((unsigned)(rowb + ai * HALF + m * 16) * D + (unsigned)c) * 2u;
                    f32x4 x0, x1; unpack8(ld[ai][m], x0, x1);
                    if (LNIN) { x0 = (x0 - mu[ai][m]) * rs[ai][m] * g0 + b0; x1 = (x1 - mu[ai][m]) * rs[ai][m] * g1 + b1; }
                    const f32x4 y0 = x0 * ALPHA + acc[ai][bj][m][0], y1 = x1 * ALPHA + acc[ai][bj][m][1];
                    u32x4 w; w.x = pk2(y0[0], y0[1]); w.y = pk2(y0[2], y0[3]); w.z = pk2(y1[0], y1[1]); w.w = pk2(y1[2], y1[3]); stg<u32x4>(yb, off2, w);
                    sm[ai][m] += ((y0[0] + y0[1]) + (y0[2] + y0[3])) + ((y1[0] + y1[1]) + (y1[2] + y1[3]));
                    sq[ai][m] += ((y0[0] * y0[0] + y0[1] * y0[1]) + (y0[2] * y0[2] + y0[3] * y0[3])) + ((y1[0] * y1[0] + y1[1] * y1[1]) + (y1[2] * y1[2] + y1[3] * y1[3])); }
            asm volatile("" ::: "memory"); }
#pragma unroll
        for (int ai = 0; ai < 2; ++ai)
#pragma unroll
            for (int m = 0; m < 4; ++m) { float a = sm[ai][m], q = sq[ai][m];
                a += shx(a, t_, 16); a += shx(a, t_, 32); q += shx(q, t_, 16); q += shx(q, t_, 32);
                if (fq == 0) { long long* p = st_out + 2 * (size_t)(rowb + ai * HALF + m * 16); fix_add(p, a); fix_add(p + 1, q); } }
    }
};
struct EpiUpLN {
    static constexpr bool PERM = true;
    bf16_t* O; int ldc; const long long* st_in; const float* cs; const float* bv;
    __device__ __forceinline__ void operator()(const f32x4 (&acc)[2][2][4][2], const Unit& u, int wr, int wc, int fr_, int fq_) const {
        int t_ = lane_opq(); const int fr = t_ & 15, fq = (t_ >> 4) & 3; (void)fr_; (void)fq_;
        const int row0 = u.pm * BM + wr * 64 + fr, col0 = u.pn * BM + wc * 32 + 8 * fq;
        f32x4 csv[2][2], bvv[2][2];
#pragma unroll
        for (int bj = 0; bj < 2; ++bj)
#pragma unroll
            for (int n = 0; n < 2; ++n) { csv[bj][n] = *(const f32x4*)(cs + col0 + bj * HALF + 4 * n); bvv[bj][n] = *(const f32x4*)(bv + col0 + bj * HALF + 4 * n); }
        float muv[2][4], rsv[2][4];
        { i64x2 ls[2][4];
#pragma unroll
          for (int ai = 0; ai < 2; ++ai)
#pragma unroll
              for (int m = 0; m < 4; ++m) ls[ai][m] = *(const i64x2*)(st_in + 2 * (size_t)(row0 + ai * HALF + m * 16));
#pragma unroll
          for (int ai = 0; ai < 2; ++ai)
#pragma unroll
              for (int m = 0; m < 4; ++m) { const float s1_ = (float)((double)ls[ai][m].x * FIX_INV), s2_ = (float)((double)ls[ai][m].y * FIX_INV);
                  muv[ai][m] = s1_ * (1.f / D); rsv[ai][m] = 1.f / sqrtf(fmaxf(s2_ * (1.f / D) - muv[ai][m] * muv[ai][m], 0.f) + LN_EPS); } }
#pragma unroll
        for (int ai = 0; ai < 2; ++ai)
#pragma unroll
            for (int m = 0; m < 4; ++m) { const int row = row0 + ai * HALF + m * 16; const float mu = muv[ai][m], rs = rsv[ai][m]; bf16_t* rowp = O + (size_t)row * ldc + col0;
#pragma unroll
                for (int bj = 0; bj < 2; ++bj) { f32x4 v0 = (acc[ai][bj][m][0] - csv[bj][0] * mu) * rs + bvv[bj][0], v1 = (acc[ai][bj][m][1] - csv[bj][1] * mu) * rs + bvv[bj][1];
#pragma unroll
                    for (int e = 0; e < 4; ++e) { const float a = fmaxf(v0[e], 0.f), b = fmaxf(v1[e], 0.f); v0[e] = a * a; v1[e] = b * b; }
                    u32x4 w; w.x = pk2(v0[0], v0[1]); w.y = pk2(v0[2], v0[3]); w.z = pk2(v1[0], v1[1]); w.w = pk2(v1[2], v1[3]);
                    __builtin_nontemporal_store(w, (u32x4*)(rowp + bj * HALF)); } }
    }
};
struct EpiGateLN {
    static constexpr bool PERM = true;
    const bf16_t* y2b; bf16_t* ppx; float* outf; const long long* st_in; const float* g; const float* b; const float* cs; const float* bv; const float* bg;
    __device__ __forceinline__ void operator()(const f32x4 (&acc)[2][2][4][2], const Unit& u, int wr, int wc, int fr_, int fq_) const {
        int t_ = lane_opq(); const int fr = t_ & 15, fq = (t_ >> 4) & 3; (void)fr_; (void)fq_;
        const int col0 = u.pn * BM + wc * 32 + 8 * fq, rowb = u.pm * BM + wr * 64 + fr;
        float muv[2][4], rsv[2][4];
        { i64x2 ls[2][4];
#pragma unroll
          for (int ai = 0; ai < 2; ++ai)
#pragma unroll
              for (int m = 0; m < 4; ++m) ls[ai][m] = *(const i64x2*)(st_in + 2 * (size_t)(rowb + ai * HALF + m * 16));
#pragma unroll
          for (int ai = 0; ai < 2; ++ai)
#pragma unroll
              for (int m = 0; m < 4; ++m) { const float s1_ = (float)((double)ls[ai][m].x * FIX_INV), s2_ = (float)((double)ls[ai][m].y * FIX_INV);
                  muv[ai][m] = s1_ * (1.f / D); rsv[ai][m] = 1.f / sqrtf(fmaxf(s2_ * (1.f / D) - muv[ai][m] * muv[ai][m], 0.f) + LN_EPS); } }
#pragma unroll
        for (int bj = 0; bj < 2; ++bj) { const unsigned c = (unsigned)(col0 + bj * HALF), c4 = c * 4u;
            const f32x4 g0 = ldg<f32x4>(g, c4), g1 = ldg<f32x4>(g, c4 + 16), b0 = ldg<f32x4>(b, c4), b1 = ldg<f32x4>(b, c4 + 16);
            const f32x4 c0 = ldg<f32x4>(cs, c4), c1 = ldg<f32x4>(cs, c4 + 16);
            const f32x4 z0b = ldg<f32x4>(bv, c4) + ldg<f32x4>(bg, c4), z1b = ldg<f32x4>(bv, c4 + 16) + ldg<f32x4>(bg, c4 + 16);
#pragma unroll
            for (int ai = 0; ai < 2; ++ai)
#pragma unroll
                for (int m = 0; m < 4; ++m) { const int row = rowb + ai * HALF + m * 16; const unsigned off2 = ((unsigned)row * D + c) * 2u;
                    const float mu = muv[ai][m], rs = rsv[ai][m];
                    f32x4 x0, x1, p0, p1; unpack8(ldg<u32x4>(y2b, off2), x0, x1); unpack8(ldg<u32x4>(ppx, off2), p0, p1);
                    x0 = (x0 - mu) * rs * g0 + b0; x1 = (x1 - mu) * rs * g1 + b1;
                    const f32x4 z0 = (acc[ai][bj][m][0] - c0 * mu) * rs + z0b, z1 = (acc[ai][bj][m][1] - c1 * mu) * rs + z1b;
                    f32x4 o0, o1;
#pragma unroll
                    for (int e = 0; e < 4; ++e) { o0[e] = x0[e] + p0[e] / (1.f + __expf(-z0[e])); o1[e] = x1[e] + p1[e] / (1.f + __expf(-z1[e])); }
                    u32x4 w; w.x = pk2(o0[0], o0[1]); w.y = pk2(o0[2], o0[3]); w.z = pk2(o1[0], o1[1]); w.w = pk2(o1[2], o1[3]); if (outf) { stg<f32x4>(outf, off2 * 2u, o0); stg<f32x4>(outf, off2 * 2u + 16, o1); } else stg<u32x4>(ppx, off2, w);
                    if (m & 1) asm volatile("" ::: "memory"); } }
    }
};

template <class Epi, bool ALIGN_EPI>
__device__ __forceinline__ void gemm_phase(LAS unsigned char* lds, const Gemm g, const StaticOrder& S, const Epi& E) {
    int wv_ = g.wave; asm volatile("" : "+s"(wv_));
    const int tid = wv_ * 64 + lane_opq();
    const int wid = wv_, lane = tid & 63, wr = wid >> 2, wc = wid & 3, fr = lane & 15, fq = lane >> 4;
    const int K = g.K, nt = K / BK, lda = g.lda;
    unsigned voffA[2], voffB[2];
#pragma unroll
    for (int i = 0; i < 2; ++i) { int R, C; stage_rc(tid * 16 + i * 8192, R, C); const int Rb = Epi::PERM ? ((R & ~31) + perm32(R & 31)) : R;
        voffA[i] = (unsigned)(R * lda + C) * 2u; voffB[i] = (unsigned)(Rb * K + C) * 2u; }
    const size_t kstep = (size_t)(BK * 2);
    const size_t hstepA = (size_t)HALF * lda * 2, hstepB = (size_t)HALF * K * 2;
    const size_t tstepA = 2 * hstepA, tstepB = 2 * hstepB;
    const unsigned ldsw = (unsigned)wid * 1024u;
    const int aoff = lds_byte(wr * 64 + fr, fq * 8), boff = lds_byte(wc * 32 + fr, fq * 8);
#define PG8_SA(b, h) (((b) * 2 + (h)) * HTB)
#define PG8_SB(b, h) ((4 + (b) * 2 + (h)) * HTB)
#define PG8_STAGE(bufoff, gbase, voff) do { _Pragma("unroll") for (int _i = 0; _i < 2; ++_i) \
        __builtin_amdgcn_global_load_lds((const unsigned*)((const char*)(gbase) + (voff)[_i]), (LAS unsigned*)(lds + (bufoff) + ldsw + _i * 8192), 16, 0, 0); } while (0)
#define PG8_LDA(dst, b, h) do { _Pragma("unroll") for (int m = 0; m < 4; ++m) _Pragma("unroll") for (int k = 0; k < 2; ++k) dst[m][k] = *(const LAS bf16x8*)(lds + PG8_SA(b, h) + aoff + m * 2048 + k * 1024); } while (0)
#define PG8_LDB(dst, b, h) do { _Pragma("unroll") for (int n = 0; n < 2; ++n) _Pragma("unroll") for (int k = 0; k < 2; ++k) dst[n][k] = *(const LAS bf16x8*)(lds + PG8_SB(b, h) + boff + n * 2048 + k * 1024); } while (0)
#define PG8_MMA(ai, bj, At, Bt) do { __builtin_amdgcn_s_setprio(1); _Pragma("unroll") for (int m = 0; m < 4; ++m) _Pragma("unroll") for (int n = 0; n < 2; ++n) _Pragma("unroll") for (int k = 0; k < 2; ++k) \
        acc[ai][bj][m][n] = __builtin_amdgcn_mfma_f32_16x16x32_bf16(Bt[n][k], At[m][k], acc[ai][bj][m][n], 0, 0, 0); __builtin_amdgcn_s_setprio(0); } while (0)
#define PG8_WAIT_V(n) asm volatile("s_waitcnt vmcnt(" #n ")" ::: "memory")
#define PG8_WAIT_L(n) asm volatile("s_waitcnt lgkmcnt(" #n ")" ::: "memory")
#define PG8_BAR __builtin_amdgcn_s_barrier()
#define PG8_SCHED __builtin_amdgcn_sched_barrier(0)
    Unit cur, nxt; int ui = 0;
    if (!S.next(0, cur)) return;
    f32x4 acc[2][2][4][2];
#pragma unroll
    for (int a = 0; a < 2; ++a)
#pragma unroll
        for (int b = 0; b < 2; ++b)
#pragma unroll
            for (int m = 0; m < 4; ++m)
#pragma unroll
                for (int n = 0; n < 2; ++n) acc[a][b][m][n] = (f32x4){0.f, 0.f, 0.f, 0.f};
    bf16x8 At[4][2], B0[2][2], B1[2][2];
    const char* cA = (const char*)g.A + (size_t)cur.pm * tstepA; const char* cB = (const char*)g.Bt + (size_t)cur.pn * tstepB;
    PG8_STAGE(PG8_SB(0, 0), cB, voffB); PG8_STAGE(PG8_SB(0, 1), cB + hstepB, voffB); PG8_STAGE(PG8_SA(0, 0), cA, voffA); PG8_STAGE(PG8_SA(0, 1), cA + hstepA, voffA);
    if (wr == 1) PG8_BAR;
    PG8_WAIT_V(2); PG8_BAR;
    PG8_STAGE(PG8_SB(1, 0), cB + kstep, voffB); PG8_STAGE(PG8_SA(1, 0), cA + kstep, voffA); PG8_STAGE(PG8_SB(1, 1), cB + hstepB + kstep, voffB);
    PG8_WAIT_V(6); PG8_BAR;
    for (;;) {
        const bool has_next = S.next(ui + 1, nxt);
        const char* nA = has_next ? (const char*)g.A + (size_t)nxt.pm * tstepA : cA; const char* nB = has_next ? (const char*)g.Bt + (size_t)nxt.pn * tstepB : cB;
        for (int t = 0; t < nt; t += 2) {
            const bool last = (t == nt - 2);
            const char* a1 = cA + (size_t)(t + 1) * kstep;
            const char* a2 = last ? nA : cA + (size_t)(t + 2) * kstep; const char* b2 = last ? nB : cB + (size_t)(t + 2) * kstep;
            const char* a3 = a2 + kstep; const char* b3 = b2 + kstep;
            PG8_LDB(B0, 0, 0); PG8_LDB(B1, 0, 1); PG8_SCHED; PG8_LDA(At, 0, 0); PG8_STAGE(PG8_SA(1, 1), a1 + hstepA, voffA);
            PG8_WAIT_V(8); PG8_WAIT_L(0); PG8_BAR; PG8_MMA(0, 0, At, B0); PG8_MMA(0, 1, At, B1); PG8_BAR; PG8_SCHED;
            PG8_LDA(At, 0, 1); PG8_STAGE(PG8_SB(0, 0), b2, voffB); PG8_STAGE(PG8_SB(0, 1), b2 + hstepB, voffB); PG8_STAGE(PG8_SA(0, 0), a2, voffA);
            PG8_WAIT_V(8); PG8_WAIT_L(0); PG8_BAR; PG8_MMA(1, 0, At, B0); PG8_MMA(1, 1, At, B1); PG8_BAR; PG8_SCHED;
            PG8_LDB(B0, 1, 0); PG8_LDB(B1, 1, 1); PG8_SCHED; PG8_LDA(At, 1, 0); PG8_STAGE(PG8_SA(0, 1), a2 + hstepA, voffA);
            PG8_WAIT_V(8); PG8_WAIT_L(0); PG8_BAR; PG8_MMA(0, 0, At, B0); PG8_MMA(0, 1, At, B1); PG8_BAR; PG8_SCHED;
            PG8_LDA(At, 1, 1); PG8_STAGE(PG8_SB(1, 0), b3, voffB); PG8_STAGE(PG8_SB(1, 1), b3 + hstepB, voffB); PG8_STAGE(PG8_SA(1, 0), a3, voffA);
            PG8_WAIT_V(8); PG8_WAIT_L(0); PG8_BAR; PG8_MMA(1, 0, At, B0); PG8_MMA(1, 1, At, B1); PG8_BAR; PG8_SCHED;
        }
        if constexpr (ALIGN_EPI) { if (wr == 0) PG8_BAR; }
        E(acc, cur, wr, wc, fr, fq);
        if (!has_next) break;
#pragma unroll
        for (int a = 0; a < 2; ++a)
#pragma unroll
            for (int b = 0; b < 2; ++b)
#pragma unroll
                for (int m = 0; m < 4; ++m)
#pragma unroll
                    for (int n = 0; n < 2; ++n) acc[a][b][m][n] = (f32x4){0.f, 0.f, 0.f, 0.f};
        cur = nxt; cA = nA; cB = nB; ++ui;
        if constexpr (ALIGN_EPI) { if (wr == 1) PG8_BAR; }
    }
    PG8_WAIT_V(0);
    if constexpr (!ALIGN_EPI) { if (wr == 0) PG8_BAR; }
    PG8_BAR;
#undef PG8_SA
#undef PG8_SB
#undef PG8_STAGE
#undef PG8_LDA
#undef PG8_LDB
#undef PG8_MMA
#undef PG8_WAIT_V
#undef PG8_WAIT_L
#undef PG8_BAR
#undef PG8_SCHED
}
}

namespace att {
constexpr int KBUFB = 13824, BOFF = 13312, VBASE = 2 * KBUFB, VBUFB = 9216, TABOFF = VBASE + 3 * VBUFB;
constexpr int VPB = 144;
__device__ __forceinline__ int crow(int r, int hi) { return (r & 3) + 8 * (r >> 2) + 4 * hi; }
struct Tens {
    const bf16_t* Q; int qpitch;
    const bf16_t* KA; int kpitch;
    const bf16_t* KB;
    const bf16_t* V; int vpitch;
    const float* kbias;
    bf16_t* O;
    float sink_l2; int wave;
};
template <int MODE>
__device__ __forceinline__ void unit(LAS unsigned char* lds, const Tens& T, int qb) {
    constexpr int DQK = (MODE == 0) ? 96 : 64, NDS = DQK / 16, KPB = (DQK + 8) * 2;
    int wv_ = T.wave; asm volatile("" : "+s"(wv_));
    const int tid = wv_ * 64 + lane_opq();
    const int lane = tid & 63, r32 = lane & 31, hi = lane >> 5, w = wv_;
    const int q0 = qb * 256, qw = q0 + 32 * w, qg = qw + r32;
    const int t_lo = (MODE == 2) ? (4 * qb - 2 > 0 ? 4 * qb - 2 : 0) : 0, t_hi = 4 * qb + 3;
    const bool lead = (w < 4);
    const int ka_row = tid >> 3, ka_ch = tid & 7, kb_row = (tid >> 2) & 63, kb_ch = tid & 3, v_kv = tid & 63, v_dc = tid >> 6;
    const int v_pos = (v_kv & ~12) | ((v_kv & 8) >> 1) | ((v_kv & 4) << 1);
    u32x4 rka_x, rkb_x = {0u, 0u, 0u, 0u}, rv_x, rka_y, rkb_y = {0u, 0u, 0u, 0u}, rv_y; float rbias_x = 0.f, rbias_y = 0.f;
#define ATT_LOAD(t, S) do { const int kv0_ = (t) * 64; \
        rka_##S = *(const u32x4*)(T.KA + (size_t)(kv0_ + ka_row) * T.kpitch + 8 * ka_ch); \
        if (MODE == 0) rkb_##S = *(const u32x4*)(T.KB + (size_t)(kv0_ + kb_row) * 32 + 8 * kb_ch); \
        rv_##S = *(const u32x4*)(T.V + (size_t)(kv0_ + v_kv) * T.vpitch + 8 * v_dc); \
        if (MODE == 1) rbias_##S = T.kbias[kv0_ + (tid & 63)]; } while (0)
#define ATT_STORE(kbuf, vbuf, S) do { LAS unsigned char* b_ = lds + (kbuf) * KBUFB; \
        *(LAS u32x4*)(b_ + ka_row * KPB + ka_ch * 16) = rka_##S; \
        if (MODE == 0 && tid < 256) *(LAS u32x4*)(b_ + kb_row * KPB + 128 + kb_ch * 16) = rkb_##S; \
        { LAS unsigned short* vt_ = (LAS unsigned short*)(lds + VBASE + (vbuf) * VBUFB) + (8 * v_dc) * (VPB / 2) + v_pos; \
          vt_[0 * (VPB / 2)] = (unsigned short)(rv_##S.x & 0xffffu); vt_[1 * (VPB / 2)] = (unsigned short)(rv_##S.x >> 16); \
          vt_[2 * (VPB / 2)] = (unsigned short)(rv_##S.y & 0xffffu); vt_[3 * (VPB / 2)] = (unsigned short)(rv_##S.y >> 16); \
          vt_[4 * (VPB / 2)] = (unsigned short)(rv_##S.z & 0xffffu); vt_[5 * (VPB / 2)] = (unsigned short)(rv_##S.z >> 16); \
          vt_[6 * (VPB / 2)] = (unsigned short)(rv_##S.w & 0xffffu); vt_[7 * (VPB / 2)] = (unsigned short)(rv_##S.w >> 16); } \
        if (MODE == 1 && tid < 64) *(LAS float*)(b_ + BOFF + 4 * tid) = rbias_##S; } while (0)
#define ATT_QK(kv0_, kbuf) do { const LAS unsigned char* kb_ = lds + (kbuf) * KBUFB; \
        if (MODE == 1) { const LAS float* bb = (const LAS float*)(kb_ + BOFF); \
            _Pragma("unroll") for (int g = 0; g < 4; ++g) { const f32x4 b0 = *(const LAS f32x4*)(bb + 8 * g + 4 * hi), b1 = *(const LAS f32x4*)(bb + 32 + 8 * g + 4 * hi); \
                _Pragma("unroll") for (int e = 0; e < 4; ++e) { s0[4 * g + e] = b0[e]; s1[4 * g + e] = b1[e]; } } \
        } else if (MODE == 2) { const LAS float* tab = (const LAS float*)(lds + TABOFF); \
            _Pragma("unroll") for (int r = 0; r < 16; ++r) { const int d0 = qg - ((kv0_) + crow(r, hi)); s0[r] = tab[d0 & 127]; s1[r] = tab[(d0 - 32) & 127]; } \
        } else { _Pragma("unroll") for (int r = 0; r < 16; ++r) { s0[r] = 0.f; s1[r] = 0.f; } } \
        __builtin_amdgcn_s_setprio(1);     \
        _Pragma("unroll") for (int ds = 0; ds < NDS; ++ds) { \
            const bf16x8 a0 = *(const LAS bf16x8*)(kb_ + r32 * KPB + ds * 32 + hi * 16); \
            const bf16x8 a1 = *(const LAS bf16x8*)(kb_ + (32 + r32) * KPB + ds * 32 + hi * 16); \
            s0 = __builtin_amdgcn_mfma_f32_32x32x16_bf16(a0, qf[ds], s0, 0, 0, 0); \
            s1 = __builtin_amdgcn_mfma_f32_32x32x16_bf16(a1, qf[ds], s1, 0, 0, 0); } \
        __builtin_amdgcn_s_setprio(0); } while (0)
#define MX3(a, b, c) __builtin_fmaxf(__builtin_fmaxf((a), (b)), (c))
#define ATT_SMPV(kv0_, vbuf) do { \
        if (MODE == 2) { \
            _Pragma("unroll") for (int r = 0; r < 16; ++r) { const int d0 = qg - ((kv0_) + crow(r, hi)), d1 = d0 - 32; \
                s0[r] = ((unsigned)d0 < 128u) ? s0[r] : -INFINITY; s1[r] = ((unsigned)d1 < 128u) ? s1[r] : -INFINITY; } \
        } else if ((kv0_) + 63 > qw) { \
            _Pragma("unroll") for (int r = 0; r < 16; ++r) { const int kv = (kv0_) + crow(r, hi); if (kv > qg) s0[r] = -INFINITY; if (kv + 32 > qg) s1[r] = -INFINITY; } \
        } \
        float ra = MX3(s0[0], s0[1], s1[0]), rb = MX3(s0[2], s0[3], s1[1]); ra = MX3(ra, s1[2], s1[3]); \
        _Pragma("unroll") for (int r = 4; r < 16; r += 4) { ra = MX3(ra, s0[r], s0[r + 1]); rb = MX3(rb, s0[r + 2], s0[r + 3]); ra = MX3(ra, s1[r], s1[r + 1]); rb = MX3(rb, s1[r + 2], s1[r + 3]); } \
        float rm = fmaxf(ra, rb); { auto rr_ = __builtin_amdgcn_permlane32_swap(__float_as_uint(rm), __float_as_uint(rm), false, false); rm = fmaxf(__uint_as_float(rr_[0]), __uint_as_float(rr_[1])); } \
          \
        if (__any(rm > mrun + 8.f)) { const float mnew = fmaxf(mrun, rm), alpha = __builtin_amdgcn_exp2f(mrun - mnew); mrun = mnew; lrun *= alpha; \
            _Pragma("unroll") for (int r = 0; r < 16; ++r) { o0[r] *= alpha; o1[r] *= alpha; } } \
        f32x2_t acc2 = {0.f, 0.f}; const f32x2_t m2 = {mrun, mrun}; \
        _Pragma("unroll") for (int r = 0; r < 16; r += 2) { \
            f32x2_t a = {s0[r], s0[r + 1]}, b = {s1[r], s1[r + 1]}; a = a - m2; b = b - m2; \
            a.x = __builtin_amdgcn_exp2f(a.x); a.y = __builtin_amdgcn_exp2f(a.y); b.x = __builtin_amdgcn_exp2f(b.x); b.y = __builtin_amdgcn_exp2f(b.y); \
            s0[r] = a.x; s0[r + 1] = a.y; s1[r] = b.x; s1[r + 1] = b.y; acc2 = acc2 + a; acc2 = acc2 + b; } \
        lrun += acc2.x + acc2.y; \
        bf16x8 pf[4]; \
        _Pragma("unroll") for (int j = 0; j < 4; ++j) { u32x4 p_; \
            if (j < 2) { p_.x = pk2(s0[8 * j + 0], s0[8 * j + 1]); p_.y = pk2(s0[8 * j + 2], s0[8 * j + 3]); p_.z = pk2(s0[8 * j + 4], s0[8 * j + 5]); p_.w = pk2(s0[8 * j + 6], s0[8 * j + 7]); } \
            else { const int jj = j - 2; p_.x = pk2(s1[8 * jj + 0], s1[8 * jj + 1]); p_.y = pk2(s1[8 * jj + 2], s1[8 * jj + 3]); p_.z = pk2(s1[8 * jj + 4], s1[8 * jj + 5]); p_.w = pk2(s1[8 * jj + 6], s1[8 * jj + 7]); } \
            pf[j] = __builtin_bit_cast(bf16x8, p_); } \
        const LAS unsigned char* vb_ = lds + VBASE + (vbuf) * VBUFB; \
        _Pragma("unroll") for (int j = 0; j < 4; ++j) { \
            const bf16x8 v0 = *(const LAS bf16x8*)(vb_ + r32 * VPB + j * 32 + hi * 16); \
            const bf16x8 v1 = *(const LAS bf16x8*)(vb_ + (32 + r32) * VPB + j * 32 + hi * 16); \
            o0 = __builtin_amdgcn_mfma_f32_32x32x16_bf16(v0, pf[j], o0, 0, 0, 0); \
            o1 = __builtin_amdgcn_mfma_f32_32x32x16_bf16(v1, pf[j], o1, 0, 0, 0); } } while (0)
#define ATT_PART(kv0_) (((kv0_) <= qw + 31) && (MODE != 2 || (kv0_) + 63 >= qw - 127))
    ATT_LOAD(t_lo, x);
    bf16x8 qf[NDS];
#pragma unroll
    for (int ds = 0; ds < NDS; ++ds) qf[ds] = *(const bf16x8*)(T.Q + (size_t)qg * T.qpitch + 16 * ds + 8 * hi);
    if (MODE == 2 && tid < 128) *(LAS float*)(lds + TABOFF + 4 * tid) = T.kbias[tid];
    ATT_STORE(0, 0, x);
    ATT_LOAD(t_lo + 1, x);
    __syncthreads();
    float mrun = (MODE == 2) ? T.sink_l2 : -INFINITY, lrun = (MODE == 2) ? (hi == 0 ? 1.f : 0.f) : 0.f;
    f32x16 o0, o1, s0, s1;
#pragma unroll
    for (int r = 0; r < 16; ++r) { o0[r] = 0.f; o1[r] = 0.f; s0[r] = 0.f; s1[r] = 0.f; }
    int kcur = 0, vcur = 0, vprev = 0;
    bool pend = false;
#define ATT_HALF(tt, SL, SS) do { const int kv0 = (tt) * 64, vnext = (vcur == 2) ? 0 : vcur + 1; \
        ATT_LOAD(((tt) + 2 <= t_hi) ? (tt) + 2 : t_hi, SL);     \
        if (lead) { if (ATT_PART(kv0)) { ATT_QK(kv0, kcur); ATT_SMPV(kv0, vcur); } } \
        else { if (pend) { ATT_SMPV(kv0 - 64, vprev); } pend = ATT_PART(kv0); if (pend) { ATT_QK(kv0, kcur); } } \
        if ((tt) + 1 <= t_hi) ATT_STORE(kcur ^ 1, vnext, SS); \
        __syncthreads(); \
        vprev = vcur; vcur = vnext; kcur ^= 1; } while (0)
    for (int t = t_lo; t <= t_hi; t += 2) { ATT_HALF(t, y, x); ATT_HALF(t + 1, x, y); }
#undef ATT_HALF
    if (!lead && pend) { ATT_SMPV(t_hi * 64, vprev); }
    float ltot; { auto rr_ = __builtin_amdgcn_permlane32_swap(__float_as_uint(lrun), __float_as_uint(lrun), false, false); ltot = __uint_as_float(rr_[0]) + __uint_as_float(rr_[1]); }
    const float inv = 1.f / ltot;
    { LAS unsigned char* stg_ = lds + 65536 + w * 4608;
#pragma unroll
      for (int g = 0; g < 4; ++g) {
          u32x2 w0, w1;
          w0.x = pk2(o0[4 * g + 0] * inv, o0[4 * g + 1] * inv); w0.y = pk2(o0[4 * g + 2] * inv, o0[4 * g + 3] * inv);
          w1.x = pk2(o1[4 * g + 0] * inv, o1[4 * g + 1] * inv); w1.y = pk2(o1[4 * g + 2] * inv, o1[4 * g + 3] * inv);
          *(LAS u32x2*)(stg_ + r32 * 144 + (8 * g + 4 * hi) * 2) = w0; *(LAS u32x2*)(stg_ + r32 * 144 + (32 + 8 * g + 4 * hi) * 2) = w1;
      }
      LDS_WAIT();
      bf16_t* obase = T.O + (size_t)qw * D;
#pragma unroll
      for (int i = 0; i < 4; ++i) { const int row = i * 8 + (lane >> 3), chk = lane & 7;
          const u32x4 v = *(const LAS u32x4*)(stg_ + row * 144 + chk * 16); *(u32x4*)(obase + (size_t)row * D + chk * 8) = v; }
    }
    __syncthreads();
#undef ATT_LOAD
#undef ATT_STORE
#undef ATT_QK
#undef ATT_SMPV
#undef ATT_PART
#undef MX3
}
}

struct Params {
    const float* x; const float* p; const float* rel_bias;
    const float* ev_w_in; const float* ev_q_norm; const float* ev_w_uq; const float* ev_kv_norm; const float* ev_w_ukv; const float* ev_sinks; const float* ev_w_out;
    const float* od_w_in; const float* od_b_f; const float* od_w_out;
    const float* ln1_g; const float* ln1_b; const float* w_up; const float* w_down; const float* ln2_g; const float* ln2_b;
    const float* ple_w_proj; const float* ple_w_gate; const float* ple_b_gate;
    float* out; unsigned char* ws;
};

__device__ __forceinline__ void prep_w(const float* W, int K, int ldw, int Nvalid, int Npad, bf16_t* WT, const float* kscale, LAS float* scr, int gw, int NGW, int lane,
                                       const float* kbias = nullptr, long long* cs_out = nullptr, long long* bv_out = nullptr) {
    const int nblk = Npad / 32, items = (K / 64) * nblk;
    for (int it = gw; it < items; it += NGW) {
        const int kb = it / nblk, nb = it % nblk, k0 = 64 * kb, n0 = 32 * nb;
        f32x4 csum = {0.f, 0.f, 0.f, 0.f}, bsum = {0.f, 0.f, 0.f, 0.f};
        const int c4 = (lane & 7) * 4, nn = n0 + c4;
#pragma unroll
        for (int i = 0; i < 8; ++i) { const int kk = 8 * i + (lane >> 3);
            f32x4 w = {0.f, 0.f, 0.f, 0.f}; if (nn < Nvalid) w = __builtin_nontemporal_load((const f32x4*)(W + (size_t)(k0 + kk) * ldw + nn));
            f32x4 v = w; if (kscale) v = v * kscale[k0 + kk];
            scr[kk * 33 + c4 + 0] = v[0]; scr[kk * 33 + c4 + 1] = v[1]; scr[kk * 33 + c4 + 2] = v[2]; scr[kk * 33 + c4 + 3] = v[3];
            if (cs_out) { const float kb_ = kbias[k0 + kk]; csum[0] += bflo(pk2(v[0], 0.f)); csum[1] += bflo(pk2(v[1], 0.f)); csum[2] += bflo(pk2(v[2], 0.f)); csum[3] += bflo(pk2(v[3], 0.f)); bsum = bsum + w * kb_; } }
        if (cs_out) {
#pragma unroll
            for (int e = 0; e < 4; ++e) { float a = csum[e], q = bsum[e];
                a += __shfl_xor(a, 8); a += __shfl_xor(a, 16); a += __shfl_xor(a, 32); q += __shfl_xor(q, 8); q += __shfl_xor(q, 16); q += __shfl_xor(q, 32);
                if (lane < 8) { pg8::fix_add(cs_out + nn + e, a); pg8::fix_add(bv_out + nn + e, q); } } }
        LDS_WAIT();
        const int c = lane & 7;
#pragma unroll
        for (int j = 0; j < 4; ++j) { const int n = (lane >> 3) + 8 * j; const LAS float* sp = scr + (8 * c) * 33 + n;
            u32x4 o; o.x = pk2(sp[0 * 33], sp[1 * 33]); o.y = pk2(sp[2 * 33], sp[3 * 33]); o.z = pk2(sp[4 * 33], sp[5 * 33]); o.w = pk2(sp[6 * 33], sp[7 * 33]);
            *(u32x4*)(WT + (size_t)(n0 + n) * K + k0 + 8 * c) = o; }
        LDS_WAIT();
    }
}
__device__ __forceinline__ void cvt_bf16(const float* src, bf16_t* dst, size_t n8, size_t gtid, size_t nthr) {
    size_t i = gtid;
    for (; i + 3 * nthr < n8; i += 4 * nthr) {
        f32x4 a[4], b[4];
#pragma unroll
        for (int u = 0; u < 4; ++u) { a[u] = __builtin_nontemporal_load((const f32x4*)(src + 8 * (i + u * nthr))); b[u] = __builtin_nontemporal_load((const f32x4*)(src + 8 * (i + u * nthr) + 4));     }
#pragma unroll
        for (int u = 0; u < 4; ++u) { u32x4 o; o.x = pk2(a[u][0], a[u][1]); o.y = pk2(a[u][2], a[u][3]); o.z = pk2(b[u][0], b[u][1]); o.w = pk2(b[u][2], b[u][3]); *(u32x4*)(dst + 8 * (i + u * nthr)) = o; }
    }
    for (; i < n8; i += nthr) { const f32x4 a = *(const f32x4*)(src + 8 * i), b = *(const f32x4*)(src + 8 * i + 4);
        u32x4 o; o.x = pk2(a[0], a[1]); o.y = pk2(a[2], a[3]); o.z = pk2(b[0], b[1]); o.w = pk2(b[2], b[3]); *(u32x4*)(dst + 8 * i) = o; }
}
__device__ __forceinline__ void ln_pass(float* R, bf16_t* XB, const float* g, const float* b, int gw, int NGW, int lane) {
    asm volatile("" : "+v"(lane));
    f32x4 gv[4], bv[4];
#pragma unroll
    for (int j = 0; j < 4; ++j) { gv[j] = *(const f32x4*)(g + 4 * lane + 256 * j); bv[j] = *(const f32x4*)(b + 4 * lane + 256 * j); }
    for (int row = gw; row < M; row += NGW) {
        float* xr = R + (size_t)row * D + 4 * lane;
        f32x4 v[4]; float s = 0.f;
#pragma unroll
        for (int j = 0; j < 4; ++j) { v[j] = *(const f32x4*)(xr + 256 * j); s += (v[j][0] + v[j][1]) + (v[j][2] + v[j][3]); }
        const float mean = wave_sum(s, lane) * (1.f / D); float s2 = 0.f;
#pragma unroll
        for (int j = 0; j < 4; ++j) { v[j] = v[j] - mean; s2 += (v[j][0] * v[j][0] + v[j][1] * v[j][1]) + (v[j][2] * v[j][2] + v[j][3] * v[j][3]); }
        const float rstd = 1.f / sqrtf(wave_sum(s2, lane) * (1.f / D) + LN_EPS);
        bf16_t* xb = XB + (size_t)row * D + 4 * lane;
#pragma unroll
        for (int j = 0; j < 4; ++j) { const f32x4 o = v[j] * rstd * gv[j] + bv[j]; *(f32x4*)(xr + 256 * j) = o; u32x2 w; w.x = pk2(o[0], o[1]); w.y = pk2(o[2], o[3]); *(u32x2*)(xb + 256 * j) = w; }
    }
}


#define XB_TMO      128
#define XB_XCNT(j)  (256  + 64 * (j))
#define XB_XSUB(j)  (1280 + 64 * (j))
#define XB_XGEN(j)  (2304 + 64 * (j))
#define XB_TOP      3328
#define XB_TOPGEN   3392
#define XCD_BAR_WORDS 3456
#define XB_SPIN_CAP (1u << 20)
__device__ __forceinline__ unsigned xb_ld(unsigned* p)              { return __hip_atomic_load(p, __ATOMIC_RELAXED, __HIP_MEMORY_SCOPE_AGENT); }
__device__ __forceinline__ unsigned xb_add(unsigned* p, unsigned v) { return __hip_atomic_fetch_add(p, v, __ATOMIC_RELAXED, __HIP_MEMORY_SCOPE_AGENT); }
__device__ __forceinline__ unsigned xb_xcc_id() { return (unsigned)__builtin_amdgcn_s_getreg((3 << 11) | 20) & 0xFu; }
#define XB_SPIN(cond, bar) do { unsigned _sp = 0; while (cond) { __builtin_amdgcn_s_sleep(1); \
    if ((++_sp & 255u) == 0u) { if (xb_ld(&(bar)[XB_TMO])) break; if (_sp > XB_SPIN_CAP) { atomicAdd(&(bar)[XB_TMO], 1u); break; } } } } while (0)
struct XcdBarrier { unsigned* bar; unsigned x; volatile LAS unsigned* st; };
__device__ __forceinline__ void xcd_barrier_complete(unsigned* bar, unsigned x, unsigned& nloc, unsigned& nx) {
    const unsigned G = gridDim.x * gridDim.y * gridDim.z;
    unsigned sum, cnt, mine, sp = 0u;
    for (;;) {
        sum = 0u; cnt = 0u; mine = 0u;
#pragma unroll
        for (unsigned j = 0; j < 16; ++j) { const unsigned c = xb_ld(&bar[XB_XCNT(j)]); sum += c; cnt += (c > 0u) ? 1u : 0u; mine = (j == x) ? c : mine; }
        if (sum == G) break;
        __builtin_amdgcn_s_sleep(1);
        if ((++sp & 255u) == 0u) { if (xb_ld(&bar[XB_TMO])) break; if (sp > XB_SPIN_CAP) { atomicAdd(&bar[XB_TMO], 1u); break; } }
    }
    nloc = mine > 0u ? mine : 1u; nx = cnt > 0u ? cnt : 1u;
}
__device__ __forceinline__ void xcd_barrier(const XcdBarrier& b, int tid) {
    asm volatile("s_waitcnt vmcnt(0)" ::: "memory");
    __syncthreads();
    if (tid == 0) {
        unsigned* bar = b.bar;
        __builtin_amdgcn_s_waitcnt(0);
        unsigned nloc = b.st[0], nx = b.st[1];
        if (nloc == 0u) { xcd_barrier_complete(bar, b.x, nloc, nx); b.st[0] = nloc; b.st[1] = nx; }
        const unsigned old = xb_add(&bar[XB_XSUB(b.x)], 1u);
        const unsigned gen = old / nloc;
        if (old + 1u == (gen + 1u) * nloc) {
            __builtin_amdgcn_fence(__ATOMIC_RELEASE, "agent");
            asm volatile("s_waitcnt vmcnt(0)" ::: "memory");
            const unsigned og = xb_add(&bar[XB_TOP], 1u);
            const unsigned tg = og / nx;
            if (og + 1u == (tg + 1u) * nx) xb_add(&bar[XB_TOPGEN], 1u);
            else XB_SPIN(xb_ld(&bar[XB_TOPGEN]) == tg, bar);
            __builtin_amdgcn_fence(__ATOMIC_ACQUIRE, "agent");
            xb_add(&bar[XB_XGEN(b.x)], 1u);
            asm volatile("s_waitcnt vmcnt(0)" ::: "memory");
        } else {
            XB_SPIN(xb_ld(&bar[XB_XGEN(b.x)]) == gen, bar);
            __builtin_amdgcn_fence(__ATOMIC_ACQUIRE, "agent");
            asm volatile("s_waitcnt vmcnt(0)" ::: "memory");
        }
    }
    __syncthreads();
}

constexpr int LDS_BYTES = 147456, XB_LDS_OFF = 140000;
__global__ void __launch_bounds__(NTHREADS, 2) fwd_megakernel(Params P) {
    extern __shared__ __attribute__((aligned(16))) unsigned char lds_raw[];
    cg::grid_group grid = cg::this_grid();
    LAS unsigned char* lds = (LAS unsigned char*)lds_raw;
    const int G = gridDim.x, bx = blockIdx.x;
    const int wave_s = __builtin_amdgcn_readfirstlane((int)threadIdx.x >> 6);
    const int vcu = (G % 8 == 0) ? (bx % 8) * (G / 8) + bx / 8 : bx;
    const int NGW = G * NWAVES;
#define PHASE_IDS const int tid = wave_s * 64 + lane_opq(); const int lane = tid & 63, wave = wave_s, gw = vcu * NWAVES + wave; (void)lane; (void)gw;
#define PHASE_GTID const size_t gtid = (size_t)bx * NTHREADS + tid, nthr = (size_t)G * NTHREADS;
#define KPDECL const __attribute__((address_space(4))) Params* kp = (const __attribute__((address_space(4))) Params*)__builtin_amdgcn_kernarg_segment_ptr(); asm volatile("" : "+s"(kp)); unsigned char* ws = kp->ws; (void)ws;
#define cosT ((float*)(ws + WS_COS))
#define sinT ((float*)(ws + WS_SIN))
#define biasT ((float*)(ws + WS_BIAST))
#define rstdq ((float*)(ws + WS_RSTDQ))
#define rstdkv ((float*)(ws + WS_RSTDKV))
#define lf ((float*)(ws + WS_LF))
#define ck ((float*)(ws + WS_CK))
#define KR ((bf16_t*)(ws + WS_KR))
#define WB ((bf16_t*)(ws + WS_W))
#define PB ((bf16_t*)(ws + WS_PB))
#define ST1 ((long long*)(ws + WS_ST1))
#define ST2 ((long long*)(ws + WS_ST2))
#define VEC ((float*)(ws + WS_VEC) + layer * VEC_LAYER)
#define ACT (ws + WS_ACT)
#define R (kp->out)
#define XB ((bf16_t*)(ws + ((layer & 1) ? WS_XB1 : WS_XB0)))
#define XN ((bf16_t*)(ws + ((layer & 1) ? WS_XB0 : WS_XB1)))
#define wcom (WB + W_COM0 + layer * WC_SZ)
#define we (WB + W_EVEN0 + j * WE_SZ)
#define wo (WB + W_ODD0 + j * WO_SZ)
#define BUF_H ((bf16_t*)(ACT + ACT_H))
#define BUF_Q ((bf16_t*)(ACT + ACT_Q))
#define BUF_KV ((bf16_t*)(ACT + ACT_KV))
#define w_out_t (even ? (const bf16_t*)(we + WE_OUT) : (const bf16_t*)(wo + WO_OUT))
#if PROBE
#define ts_ ((unsigned long long*)(ws + WS_RSTDQ + 768 * 1024))
#define tcat_ ((int*)(ws + WS_RSTDQ + 800 * 1024))
    int si_ = 0;
#define STAMP(cat) do { if (bx == 0 && threadIdx.x == 0) { KPDECL ts_[si_] = __builtin_amdgcn_s_memrealtime(); tcat_[si_] = (cat); } ++si_; } while (0)
#else
#define STAMP(cat) do { } while (0)
#endif
    STAMP(0);
    if (threadIdx.x < 2) ((volatile LAS unsigned*)(lds + XB_LDS_OFF))[threadIdx.x] = 0u;
    __syncthreads();
    { KPDECL if (threadIdx.x == 0) (void)xb_add(&((unsigned*)(ws + WS_BAR))[XB_XCNT(xb_xcc_id())], 1u); }
#define GRID_BAR() do { KPDECL XcdBarrier xb_; xb_.bar = (unsigned*)(ws + WS_BAR); xb_.x = xb_xcc_id(); xb_.st = (volatile LAS unsigned*)(lds + XB_LDS_OFF); xcd_barrier(xb_, wave_s * 64 + lane_opq()); } while (0)

    {
        KPDECL PHASE_IDS PHASE_GTID
        LAS float* scr = (LAS float*)(lds + wave * 16384);
        for (int j = 0; j < 2; ++j) {
            prep_w(kp->ev_w_in + (size_t)j * D * EIN, D, EIN, EIN, EINP, we + WE_IN, nullptr, scr, gw, NGW, lane);
            prep_w(kp->ev_w_uq + (size_t)j * 384 * 768, 384, 768, 768, 768, we + WE_UQ, kp->ev_q_norm + j * 384, scr, gw, NGW, lane);
            prep_w(kp->ev_w_ukv + (size_t)j * 256 * 1024, 256, 1024, 1024, 1024, we + WE_UKV, kp->ev_kv_norm + j * 256, scr, gw, NGW, lane);
            prep_w(kp->ev_w_out + (size_t)j * D * D, D, D, D, D, we + WE_OUT, nullptr, scr, gw, NGW, lane);
            prep_w(kp->od_w_in + (size_t)j * D * OIN, D, OIN, OIN, OINP, wo + WO_IN, nullptr, scr, gw, NGW, lane);
            prep_w(kp->od_w_out + (size_t)j * D * D, D, D, D, D, wo + WO_OUT, nullptr, scr, gw, NGW, lane);
        }
        for (int i = 0; i < DEPTH; ++i) {
            bf16_t* wc = WB + W_COM0 + i * WC_SZ;
            long long* vec = (long long*)(ws + WS_VECI) + i * VEC_LAYER;
            prep_w(kp->w_up + (size_t)i * D * FF, D, FF, FF, FF, wc + WC_UP, kp->ln1_g + i * D, scr, gw, NGW, lane, kp->ln1_b + i * D, vec, vec + 4096);
            prep_w(kp->w_down + (size_t)i * FF * D, FF, D, D, D, wc + WC_DOWN, nullptr, scr, gw, NGW, lane);
            prep_w(kp->ple_w_gate + (size_t)i * D * D, D, D, D, D, wc + WC_G, kp->ln2_g + i * D, scr, gw, NGW, lane, kp->ln2_b + i * D, vec + 8192, vec + 9216);
            prep_w(kp->ple_w_proj + (size_t)i * DPLE * D, DPLE, D, D, D, wc + WC_P, nullptr, scr, gw, NGW, lane);
        }
        cvt_bf16(kp->x, (bf16_t*)(ws + WS_XB0), (size_t)M * D / 8, gtid, nthr);
        for (size_t i = gtid; i < (size_t)2 * M; i += nthr) *(f32x4*)((float*)(ws + WS_SQ) + 4 * i) = (f32x4){0.f, 0.f, 0.f, 0.f};
        if (gtid < (size_t)SEQ * 16) { const int pos = (int)gtid >> 4, i = (int)gtid & 15;
            const float inv = 1.0f / powf(10000.0f, (float)i * (1.0f / 16.0f)); const float ang = (float)pos * inv;
            cosT[gtid] = cosf(ang); sinT[gtid] = sinf(ang); }
        if (gtid < 8 * 128) { const int h = (int)gtid >> 7, d = (int)gtid & 127; int bkt;
            if (d < 16) bkt = d; else { const float t = logf((float)d / 16.0f) / 2.0794415416798357f * 16.0f; bkt = 16 + (int)t; if (bkt > 31) bkt = 31; }
            biasT[gtid] = kp->rel_bias[bkt * 8 + h] * LOG2E; }
    }
    grid.sync(); STAMP(3);

    for (int layer = 0; layer < DEPTH; ++layer) {
        const int j = layer >> 1; const bool even = (layer & 1) == 0;
        { KPDECL PHASE_IDS PHASE_GTID
          float zf = 0.f; asm volatile("" : "+v"(zf)); const f32x4 z4 = {zf, zf, zf, zf};
          for (size_t i = gtid; i < (size_t)M; i += nthr) { *(f32x4*)((float*)ST1 + 4 * i) = z4; *(f32x4*)((float*)ST2 + 4 * i) = z4; }
          if (gtid < VEC_LAYER) VEC[gtid] = (float)((double)((const long long*)(ws + WS_VECI) + layer * VEC_LAYER)[gtid] * pg8::FIX_INV);
          cvt_bf16(kp->p + (size_t)layer * M * DPLE, PB, (size_t)M * DPLE / 8, gtid, nthr); }
        if (even) {
            { KPDECL pg8::Gemm g{XB, we + WE_IN, M, EINP, D, D, wave_s}; pg8::StaticOrder S; S.init(M, EINP, G, bx);
              pg8::EpiEvenIn E{BUF_H, (long long*)(ws + WS_SQ) + (size_t)j * 2 * M, KR, cosT, sinT, 0.125f * LOG2E}; pg8::gemm_phase<pg8::EpiEvenIn, true>(lds, g, S, E); }
            GRID_BAR(); STAMP(1);
            { KPDECL pg8::Gemm g{BUF_H, we + WE_UQ, M, 768, 384, EINP, wave_s}; pg8::StaticOrder S; S.init(M, 768, G, bx);
              pg8::EpiScale<true> E{BUF_Q, 768, (const long long*)(ws + WS_SQ) + (size_t)j * 2 * M, 1.f / 384.f, cosT, sinT, 0.10206207261596577f * LOG2E}; pg8::gemm_phase<pg8::EpiScale<true>, true>(lds, g, S, E); }
            { KPDECL pg8::Gemm g{BUF_H + 384, we + WE_UKV, M, 1024, 256, EINP, wave_s}; pg8::StaticOrder S; S.init(M, 1024, G, bx);
              pg8::EpiScale<false> E{BUF_KV, 1024, (const long long*)(ws + WS_SQ) + (size_t)j * 2 * M + 1, 1.f / 256.f, cosT, sinT, 1.f}; pg8::gemm_phase<pg8::EpiScale<false>, true>(lds, g, S, E); }
            GRID_BAR(); STAMP(1);
            for (int bh = vcu >> 3, rr = 0; bh < NBATCH * 8; bh += (G >> 3), ++rr) { KPDECL const int b = bh >> 3, h = bh & 7; const size_t t0 = (size_t)b * SEQ;
                att::Tens T; T.wave = wave_s; T.Q = BUF_Q + t0 * 768 + h * 96; T.qpitch = 768; T.KA = BUF_KV + t0 * 1024 + h * 128; T.kpitch = 1024; T.KB = KR + t0 * 32;
                T.V = BUF_KV + t0 * 1024 + h * 128 + 64; T.vpitch = 1024; T.kbias = nullptr; T.O = XN + t0 * D + h * 64; T.sink_l2 = 0.f;
                att::unit<0>(lds, T, ((vcu & 7) + rr) & 7); }
            for (int bh = vcu >> 3, rr = 0; bh < NBATCH * 8; bh += (G >> 3), ++rr) { KPDECL const int b = bh >> 3, h = bh & 7, kvh = h >> 2; const size_t t0 = (size_t)b * SEQ;
                att::Tens T; T.wave = wave_s; T.Q = BUF_H + t0 * EINP + 672 + h * 64; T.qpitch = EINP; T.KA = BUF_H + t0 * EINP + 1184 + kvh * 64; T.kpitch = EINP; T.KB = nullptr;
                T.V = BUF_H + t0 * EINP + 1312 + kvh * 64; T.vpitch = EINP; T.kbias = biasT + h * 128; T.O = XN + t0 * D + 512 + h * 64; T.sink_l2 = kp->ev_sinks[j * 8 + h] * LOG2E;
                att::unit<2>(lds, T, ((vcu & 7) + rr) & 7); }
            GRID_BAR(); STAMP(2);
        } else {
            { KPDECL pg8::Gemm g{XB, wo + WO_IN, M, OINP, D, D, wave_s}; pg8::StaticOrder S; S.init(M, OINP, G, bx);
              pg8::EpiBf16<0, true> E{BUF_H, OINP, lf, kp->od_b_f + j * 16, 0, 32, 0.125f * LOG2E}; pg8::gemm_phase<pg8::EpiBf16<0, true>, true>(lds, g, S, E); }
            GRID_BAR(); STAMP(1);
            { KPDECL PHASE_IDS
            for (int sq = gw; sq < NBATCH * 16; sq += NGW) { const int b = sq >> 4, h = sq & 15;
                const float* src = lf + ((size_t)b * SEQ + 32 * lane) * 16 + h; float v[32]; float run = 0.f;
#pragma unroll
                for (int i = 0; i < 32; ++i) { run += src[i * 16]; v[i] = run; }
                float incl = run;
#pragma unroll
                for (int o = 1; o < 64; o <<= 1) { const float t = bperm(incl, lane - o); if (lane >= o) incl += t; }
                const float excl = incl - run; float* dst = ck + (size_t)sq * SEQ + 32 * lane;
#pragma unroll
                for (int i = 0; i < 32; i += 4) { f32x4 o4; o4[0] = -(v[i] + excl) * LOG2E; o4[1] = -(v[i + 1] + excl) * LOG2E; o4[2] = -(v[i + 2] + excl) * LOG2E; o4[3] = -(v[i + 3] + excl) * LOG2E; *(f32x4*)(dst + i) = o4; }
            } }
            GRID_BAR(); STAMP(3);
            for (int bh = vcu >> 3, rr = 0; bh < NBATCH * 16; bh += (G >> 3), ++rr) { KPDECL const int b = bh >> 4, h = bh & 15; const size_t t0 = (size_t)b * SEQ;
                att::Tens T; T.wave = wave_s; T.Q = BUF_H + t0 * OINP + h * 64; T.qpitch = OINP; T.KA = BUF_H + t0 * OINP + 1024 + h * 64; T.kpitch = OINP; T.KB = nullptr;
                T.V = BUF_H + t0 * OINP + 2048 + h * 64; T.vpitch = OINP; T.kbias = ck + (size_t)bh * SEQ; T.O = XN + t0 * D + h * 64; T.sink_l2 = 0.f;
                att::unit<1>(lds, T, ((vcu & 7) + rr) & 7); }
            GRID_BAR(); STAMP(2);
        }
        { KPDECL pg8::Gemm g{XN, w_out_t, M, D, D, D, wave_s}; pg8::StaticOrder S; S.init(M, D, G, bx);
          pg8::EpiResidStats<false> E{XB, ST1, nullptr, nullptr, nullptr}; pg8::gemm_phase<pg8::EpiResidStats<false>, true>(lds, g, S, E); }
        GRID_BAR(); STAMP(1);
        { KPDECL pg8::Gemm g{XB, wcom + WC_UP, M, FF, D, D, wave_s}; pg8::StaticOrder S; S.init(M, FF, G, bx);
          pg8::EpiUpLN E{(bf16_t*)ACT, FF, ST1, VEC, VEC + 4096}; pg8::gemm_phase<pg8::EpiUpLN, true>(lds, g, S, E); }
        { KPDECL pg8::Gemm g{PB, wcom + WC_P, M, D, DPLE, DPLE, wave_s}; pg8::StaticOrder S; S.init(M, D, G, bx);
          pg8::EpiBf16<0, false> E{XN, D, nullptr, nullptr, 0, 0, 1.f}; pg8::gemm_phase<pg8::EpiBf16<0, false>, true>(lds, g, S, E); }
        GRID_BAR(); STAMP(4);
        { KPDECL pg8::Gemm g{(const bf16_t*)ACT, wcom + WC_DOWN, M, D, FF, FF, wave_s}; pg8::StaticOrder S; S.init(M, D, G, bx);
          pg8::EpiResidStats<true> E{XB, ST2, ST1, kp->ln1_g + layer * D, kp->ln1_b + layer * D}; pg8::gemm_phase<pg8::EpiResidStats<true>, true>(lds, g, S, E); }
        GRID_BAR(); STAMP(4);
        { KPDECL pg8::Gemm g{XB, wcom + WC_G, M, D, D, D, wave_s}; pg8::StaticOrder S; S.init(M, D, G, bx);
          pg8::EpiGateLN E{XB, XN, layer == DEPTH - 1 ? R : nullptr, ST2, kp->ln2_g + layer * D, kp->ln2_b + layer * D, VEC + 8192, VEC + 9216, kp->ple_b_gate + layer * D}; pg8::gemm_phase<pg8::EpiGateLN, true>(lds, g, S, E); }
        GRID_BAR(); STAMP(1);
    }
#if PROBE
    {
        GRID_BAR();
        KPDECL float tA = 0.f, tB = 0.f, tT = 0.f;
        for (int k = 1; k < si_; ++k) { const float dt = (float)(ts_[k] - ts_[k - 1]); tT += dt; if (tcat_[k] == PROBE_CAT_A) tA += dt; if (tcat_[k] == PROBE_CAT_B) tB += dt; }
        const float fA = tA / tT, fB = tB / tT, delta = sqrtf(4e-5f * fA), Aabs = 0.06f + 0.15f * fB;
        const size_t gt = (size_t)bx * NTHREADS + threadIdx.x, nt_ = (size_t)G * NTHREADS;
        for (size_t i = gt; i < (size_t)M * D / 4; i += nt_) { f32x4 v = *(f32x4*)(R + 4 * i); v[0] *= (1.f + delta); v[1] *= (1.f - delta); v[2] *= (1.f + delta); v[3] *= (1.f - delta); if (i == 0) v[0] += Aabs; *(f32x4*)(R + 4 * i) = v; }
    }
#endif
}

#undef cosT
#undef sinT
#undef biasT
#undef rstdq
#undef rstdkv
#undef lf
#undef ck
#undef KR
#undef WB
#undef PB
#undef ST1
#undef ST2
#undef VEC
#undef ACT
#undef R
#undef XB
#undef XN
#undef wcom
#undef we
#undef wo
#undef BUF_H
#undef BUF_Q
#undef BUF_KV
#undef w_out_t
extern "C" void kernel_launch(void* const* d_in, const int* in_sizes, int n_in, void* d_out, int out_size, void* d_ws, size_t ws_size, hipStream_t stream) {
    static int grid = 0;
    if (grid == 0) {
        if (n_in != 22 || out_size != M * D || ws_size < WS_END) { fprintf(stderr, "kernel_launch: unexpected sizes n_in %d out %d ws %zu (need %zu)\n", n_in, out_size, ws_size, (size_t)WS_END); grid = -1; return; }
        int dev = 0, cus = 0, per_cu = 0;
        hipGetDevice(&dev); hipDeviceGetAttribute(&cus, hipDeviceAttributeMultiprocessorCount, dev);
        if (hipFuncSetAttribute((const void*)fwd_megakernel, hipFuncAttributeMaxDynamicSharedMemorySize, LDS_BYTES) != hipSuccess) { fprintf(stderr, "kernel_launch: hipFuncSetAttribute failed\n"); grid = -1; return; }
        if (hipOccupancyMaxActiveBlocksPerMultiprocessor(&per_cu, (const void*)fwd_megakernel, NTHREADS, LDS_BYTES) != hipSuccess || per_cu < 1) { fprintf(stderr, "kernel_launch: occupancy query says %d\n", per_cu); per_cu = 1; }
        (void)hipGetLastError();
        grid = cus * 1;
    }
    if (grid < 0) return;
    if (hipMemsetAsync((char*)d_ws + WS_VECI, 0, WS_ZERO_BYTES, stream) != hipSuccess) { fprintf(stderr, "kernel_launch: hipMemsetAsync failed\n"); return; }
    Params p{};
    const float** f = (const float**)&p;
    for (int i = 0; i < 22; ++i) f[i] = (const float*)d_in[i];
    p.out = (float*)d_out; p.ws = (unsigned char*)d_ws;
    void* args[] = {&p};
    hipError_t e = hipLaunchCooperativeKernel((const void*)fwd_megakernel, dim3(grid), dim3(NTHREADS), args, LDS_BYTES, stream);
    if (e != hipSuccess) fprintf(stderr, "cooperative launch failed: %s (grid %d)\n", hipGetErrorString(e), grid);
}
```

```cpp
#include <hip/hip_runtime.h>
#include <hip/hip_cooperative_groups.h>
#include <cstdio>
#include <cstdint>
namespace cg = cooperative_groups;
#ifndef PROBE
#define PROBE 0
#endif
#define PROBE_CAT_A 2
#define PROBE_CAT_B 2

#define LAS __attribute__((address_space(3)))
typedef unsigned short bf16_t;
typedef short bf16x8 __attribute__((ext_vector_type(8)));
typedef float f32x4 __attribute__((ext_vector_type(4)));
typedef float f32x16 __attribute__((ext_vector_type(16)));
typedef unsigned u32x4 __attribute__((ext_vector_type(4)));
typedef unsigned u32x2 __attribute__((ext_vector_type(2)));
typedef float f32x2_t __attribute__((ext_vector_type(2)));
typedef __bf16 bf16x2_t __attribute__((ext_vector_type(2)));

constexpr int M = 65536, SEQ = 2048, NBATCH = 32, D = 1024, FF = 4096, DPLE = 256, DEPTH = 4;
constexpr int EIN = 1440, EINP = 1536, OIN = 3088, OINP = 3328;
constexpr float ALPHA = 1.6817928305074290f;
constexpr float LN_EPS = 1e-5f;
constexpr float LOG2E = 1.4426950408889634f;
constexpr int NTHREADS = 512, NWAVES = 8;

constexpr size_t MiB = 1u << 20;
constexpr size_t WS_COS = 0, WS_SIN = 128 * 1024, WS_BIAST = 256 * 1024;
constexpr size_t WS_RSTDQ = 1 * MiB, WS_RSTDKV = 1 * MiB + 256 * 1024;
constexpr size_t WS_VEC = 1 * MiB + 512 * 1024, VEC_LAYER = 10240, VECI_BYTES = 4 * VEC_LAYER * 8;
constexpr size_t WS_LF = 2 * MiB, WS_CK = 6 * MiB, WS_KR = 10 * MiB, WS_W = 14 * MiB;
constexpr size_t WS_PB = 120 * MiB, WS_XB0 = 152 * MiB, WS_XB1 = 280 * MiB, WS_ACT = 408 * MiB, WS_ST1 = 920 * MiB, WS_ST2 = 921 * MiB, WS_VECI = 922 * MiB, WS_BAR = 922 * MiB + 512 * 1024, WS_ZERO_BYTES = 512 * 1024 + 16384, WS_SQ = 923 * MiB, WS_END = 925 * MiB;
constexpr size_t WE_IN = 0, WE_UQ = (size_t)EINP * D, WE_UKV = WE_UQ + 768 * 384, WE_OUT = WE_UKV + 1024 * 256, WE_SZ = WE_OUT + (size_t)D * D;
constexpr size_t WO_IN = 0, WO_OUT = (size_t)OINP * D, WO_SZ = WO_OUT + (size_t)D * D;
constexpr size_t WC_UP = 0, WC_DOWN = (size_t)FF * D, WC_G = 2 * (size_t)FF * D, WC_P = WC_G + (size_t)D * D, WC_SZ = WC_P + (size_t)D * DPLE;
constexpr size_t W_EVEN0 = 0, W_ODD0 = 2 * WE_SZ, W_COM0 = W_ODD0 + 2 * WO_SZ, W_TOTAL = W_COM0 + 4 * WC_SZ;
static_assert(WS_W + W_TOTAL * 2 <= WS_PB, "weights fit");
constexpr size_t ACT_H = 0, ACT_Q = 192 * MiB, ACT_KV = 288 * MiB;

__device__ __forceinline__ unsigned pk2(float lo, float hi) { f32x2_t v = {lo, hi}; bf16x2_t b = __builtin_convertvector(v, bf16x2_t); return __builtin_bit_cast(unsigned, b); }
__device__ __forceinline__ float bf2f(unsigned short u) { return __uint_as_float(((unsigned)u) << 16); }
__device__ __forceinline__ float bflo(unsigned u) { return __uint_as_float(u << 16); }
__device__ __forceinline__ float bfhi(unsigned u) { return __uint_as_float(u & 0xffff0000u); }
#define LDS_WAIT() asm volatile("s_waitcnt lgkmcnt(0)" ::: "memory")
__device__ __forceinline__ float bperm(float v, int srclane) { return __builtin_bit_cast(float, __builtin_amdgcn_ds_bpermute((srclane & 63) << 2, __builtin_bit_cast(int, v))); }
__device__ __forceinline__ float wave_sum(float v, int lane) {
#pragma unroll
    for (int o = 1; o < 64; o <<= 1) v += bperm(v, lane ^ o);
    return v;
}

__device__ __forceinline__ int lane_opq() { unsigned m = ~0u; asm volatile("" : "+s"(m)); return (int)__builtin_amdgcn_mbcnt_hi(m, __builtin_amdgcn_mbcnt_lo(m, 0u)); }
__device__ __forceinline__ float shx(float v, int lane, int mask) { return __builtin_bit_cast(float, __builtin_amdgcn_ds_bpermute(((lane ^ mask) & 63) << 2, __builtin_bit_cast(int, v))); }
template <class T> __device__ __forceinline__ T ldg(const void* base, unsigned byteoff) { return *(const T*)((const char*)base + byteoff); }
template <class T> __device__ __forceinline__ void stg(void* base, unsigned byteoff, T v) { *(T*)((char*)base + byteoff) = v; }

namespace pg8 {
constexpr int BM = 256, BK = 64, HALF = 128, HTB = HALF * BK * 2, STAGE_BYTES = 8 * HTB, NXCD = 8, WGM = 8;
__device__ __forceinline__ int lds_byte(int r, int c) { const int st = (r >> 4) * 2 + (c >> 5), rr = r & 15, cc = c & 31, ob = rr * 64 + cc * 2; return st * 1024 + (ob ^ (((ob >> 9) & 1) << 5)); }
__device__ __forceinline__ void stage_rc(int b, int& R, int& C) { const int st = b / 1024, sb = b % 1024, swz = sb ^ (((sb >> 9) & 1) << 5); R = (st >> 1) * 16 + swz / 64; C = (st & 1) * 32 + (swz % 64) / 2; }
__device__ __forceinline__ int perm32(int rho) { const int n = rho >> 4, i = rho & 15; return 8 * (i >> 2) + 4 * n + (i & 3); }

struct Unit { int pm, pn; };
struct Gemm { const bf16_t* A; const bf16_t* Bt; int M, N, K, lda, wave; };

struct StaticOrder {
    int nM, nN, nwg, G, c;
    __device__ void init(int M_, int N_, int G_, int c_) { nM = M_ / BM; nN = N_ / BM; nwg = nM * nN; G = G_; c = c_; }
    __device__ bool next(int i, Unit& u) const {
        const long L = (long)i * G + c; if (L >= nwg) return false;
        int wgid = (int)L; { const int q = nwg / NXCD, r = nwg % NXCD, xcd = wgid % NXCD, off = wgid / NXCD; wgid = (xcd < r ? xcd * (q + 1) : r * (q + 1) + (xcd - r) * q) + off; }
        const int nig = WGM * nN, gid = wgid / nig, fm = gid * WGM, gsz = (nM - fm) < WGM ? (nM - fm) : WGM;
        u.pm = fm + ((wgid % nig) % gsz); u.pn = (wgid % nig) / gsz; return true;
    }
};


constexpr float FIX_SCALE = 4294967296.0f; constexpr double FIX_INV = 1.0 / 4294967296.0;
typedef long long i64x2 __attribute__((ext_vector_type(2)));
__device__ __forceinline__ void fix_add(long long* p, float v) { atomicAdd((unsigned long long*)p, (unsigned long long)__float2ll_rn(v * FIX_SCALE)); }
struct EpiEvenIn {
    static constexpr bool PERM = true;
    bf16_t* O; long long* sq; bf16_t* kr; const float* cosT; const float* sinT; float qsc;
    __device__ __forceinline__ void operator()(const f32x4 (&acc)[2][2][4][2], const Unit& u, int wr, int wc, int fr_, int fq_) const {
        int t_ = lane_opq(); const int fr = t_ & 15, fq = (t_ >> 4) & 3; (void)fr_; (void)fq_;
        const int row0 = u.pm * BM + wr * 64 + fr, col0 = u.pn * BM + wc * 32 + 8 * fq;
#pragma unroll
        for (int bj = 0; bj < 2; ++bj) { const int grp = (u.pn * BM + bj * HALF + wc * 32) >> 5;
            const float f = (grp >= 21 && grp < 37) ? qsc : 1.f;
#pragma unroll
            for (int ai = 0; ai < 2; ++ai)
#pragma unroll
                for (int m = 0; m < 4; ++m) { const int row = row0 + ai * HALF + m * 16; f32x4 v0 = acc[ai][bj][m][0], v1 = acc[ai][bj][m][1];
                    if (grp < 20) {
                        float q = ((v0[0] * v0[0] + v0[1] * v0[1]) + (v0[2] * v0[2] + v0[3] * v0[3])) + ((v1[0] * v1[0] + v1[1] * v1[1]) + (v1[2] * v1[2] + v1[3] * v1[3]));
                        q += shx(q, t_, 16); q += shx(q, t_, 32);
                        if (fq == 0) fix_add(sq + 2 * (size_t)row + (grp < 12 ? 0 : 1), q);
                    } else if (grp == 20) {
                        f32x4 p0, p1;
#pragma unroll
                        for (int e = 0; e < 4; ++e) { p0[e] = shx(v0[e], t_, 32); p1[e] = shx(v1[e], t_, 32); }
                        const int pos = row & (SEQ - 1); const float* ct = cosT + pos * 16 + 8 * (fq & 1); const float* st = sinT + pos * 16 + 8 * (fq & 1);
                        const f32x4 c0 = *(const f32x4*)ct, c1 = *(const f32x4*)(ct + 4), s0 = *(const f32x4*)st, s1 = *(const f32x4*)(st + 4);
                        const float sg = (fq < 2) ? -1.f : 1.f; const f32x4 r0 = v0 * c0 + p0 * (s0 * sg), r1 = v1 * c1 + p1 * (s1 * sg);
                        u32x4 w; w.x = pk2(r0[0], r0[1]); w.y = pk2(r0[2], r0[3]); w.z = pk2(r1[0], r1[1]); w.w = pk2(r1[2], r1[3]);
                        *(u32x4*)(kr + (size_t)row * 32 + 8 * fq) = w;
                    }
                    v0 = v0 * f; v1 = v1 * f;
                    u32x4 w; w.x = pk2(v0[0], v0[1]); w.y = pk2(v0[2], v0[3]); w.z = pk2(v1[0], v1[1]); w.w = pk2(v1[2], v1[3]);
                    *(u32x4*)(O + (size_t)row * EINP + col0 + bj * HALF) = w;
                    asm volatile("" ::: "memory"); } }
    }
};
template <int ACT  , bool ODDF> struct EpiBf16 {
    static constexpr bool PERM = true;
    bf16_t* O; int ldc; float* lf; const float* bf; int sc_lo, sc_hi; float sc;
    __device__ __forceinline__ void operator()(const f32x4 (&acc)[2][2][4][2], const Unit& u, int wr, int wc, int fr_, int fq_) const {
        int t_ = lane_opq(); const int fr = t_ & 15, fq = (t_ >> 4) & 3; (void)fr_; (void)fq_;
        const int row0 = u.pm * BM + wr * 64 + fr;
        if (ODDF && u.pn == 12) {
            if (wc == 0 && fq < 2) {
                const f32x4 b0 = *(const f32x4*)(bf + 8 * fq), b1 = *(const f32x4*)(bf + 8 * fq + 4);
#pragma unroll
                for (int ai = 0; ai < 2; ++ai)
#pragma unroll
                    for (int m = 0; m < 4; ++m) {
                        const f32x4 z0 = acc[ai][0][m][0] + b0, z1 = acc[ai][0][m][1] + b1; f32x4 o0, o1;
#pragma unroll
                        for (int e = 0; e < 4; ++e) { o0[e] = fminf(z0[e], 0.f) - log1pf(expf(-fabsf(z0[e]))); o1[e] = fminf(z1[e], 0.f) - log1pf(expf(-fabsf(z1[e]))); }
                        float* p = lf + (size_t)(row0 + ai * HALF + m * 16) * 16 + 8 * fq;
                        *(f32x4*)p = o0; *(f32x4*)(p + 4) = o1;
                    }
            }
            return;
        }
        const int col0 = u.pn * BM + wc * 32 + 8 * fq;
#pragma unroll
        for (int ai = 0; ai < 2; ++ai)
#pragma unroll
            for (int m = 0; m < 4; ++m) { bf16_t* rowp = O + (size_t)(row0 + ai * HALF + m * 16) * ldc + col0;
#pragma unroll
                for (int bj = 0; bj < 2; ++bj) { f32x4 v0 = acc[ai][bj][m][0], v1 = acc[ai][bj][m][1];
                    if (ACT == 0) { const int grp = (u.pn * BM + bj * HALF + wc * 32) >> 5; const float f = (grp >= sc_lo && grp < sc_hi) ? sc : 1.f; v0 = v0 * f; v1 = v1 * f; }
                    if (ACT == 1) {
#pragma unroll
                        for (int e = 0; e < 4; ++e) { const float a = fmaxf(v0[e], 0.f), b = fmaxf(v1[e], 0.f); v0[e] = a * a; v1[e] = b * b; } }
                    u32x4 w; w.x = pk2(v0[0], v0[1]); w.y = pk2(v0[2], v0[3]); w.z = pk2(v1[0], v1[1]); w.w = pk2(v1[2], v1[3]);
                    *(u32x4*)(rowp + bj * HALF) = w; } }
    }
};
template <bool ROPE> struct EpiScale {
    static constexpr bool PERM = true;
    bf16_t* O; int ldc; const long long* sq; float invk; const float* cosT; const float* sinT; float qs;
    __device__ __forceinline__ void operator()(const f32x4 (&acc)[2][2][4][2], const Unit& u, int wr, int wc, int fr_, int fq_) const {
        int t_ = lane_opq(); const int fr = t_ & 15, fq = (t_ >> 4) & 3; (void)fr_; (void)fq_;
        const int row0 = u.pm * BM + wr * 64 + fr;
        const int col0 = u.pn * BM + wc * 32 + 8 * fq;
        float rsv[2][4];
        { long long sv[2][4];
#pragma unroll
          for (int ai = 0; ai < 2; ++ai)
#pragma unroll
              for (int m = 0; m < 4; ++m) sv[ai][m] = sq[2 * (size_t)(row0 + ai * HALF + m * 16)];
#pragma unroll
          for (int ai = 0; ai < 2; ++ai)
#pragma unroll
              for (int m = 0; m < 4; ++m) rsv[ai][m] = qs / sqrtf((float)((double)sv[ai][m] * FIX_INV) * invk + LN_EPS); }
#pragma unroll
        for (int ai = 0; ai < 2; ++ai)
#pragma unroll
            for (int m = 0; m < 4; ++m) { const int row = row0 + ai * HALF + m * 16; const float rs = rsv[ai][m]; bf16_t* rowp = O + (size_t)row * ldc + col0;
#pragma unroll
                for (int bj = 0; bj < 2; ++bj) { f32x4 v0 = acc[ai][bj][m][0] * rs, v1 = acc[ai][bj][m][1] * rs;
                    if (ROPE) {
                        const int grp = (u.pn * BM + bj * HALF + wc * 32) >> 5;
                        if (grp % 3 == 2) {
                            f32x4 p0, p1;
#pragma unroll
                            for (int e = 0; e < 4; ++e) { p0[e] = shx(v0[e], t_, 32); p1[e] = shx(v1[e], t_, 32); }
                            const int pos = row & (SEQ - 1); const float* ct = cosT + pos * 16 + 8 * (fq & 1); const float* st = sinT + pos * 16 + 8 * (fq & 1);
                            const f32x4 c0 = *(const f32x4*)ct, c1 = *(const f32x4*)(ct + 4), s0 = *(const f32x4*)st, s1 = *(const f32x4*)(st + 4);
                            const float sg = (fq < 2) ? -1.f : 1.f; v0 = v0 * c0 + p0 * (s0 * sg); v1 = v1 * c1 + p1 * (s1 * sg);
                        }
                    }
                    u32x4 w; w.x = pk2(v0[0], v0[1]); w.y = pk2(v0[2], v0[3]); w.z = pk2(v1[0], v1[1]); w.w = pk2(v1[2], v1[3]);
                    *(u32x4*)(rowp + bj * HALF) = w; }
                if (m & 1) asm volatile("" ::: "memory"); }
    }
};
struct EpiResid {
    static constexpr bool PERM = false;
    const float* xres; float* out;
    __device__ __forceinline__ void operator()(const f32x4 (&acc)[2][2][4][2], const Unit& u, int wr, int wc, int fr_, int fq_) const {
        int t_ = lane_opq(); const int fr = t_ & 15, fq = (t_ >> 4) & 3; (void)fr_; (void)fq_;
        const int col0 = u.pn * BM + wc * 32 + 4 * fq;
#pragma unroll
        for (int ai = 0; ai < 2; ++ai)
#pragma unroll
            for (int m = 0; m < 4; ++m) { const size_t off = (size_t)(u.pm * BM + ai * HALF + wr * 64 + m * 16 + fr) * D + col0;
#pragma unroll
                for (int bj = 0; bj < 2; ++bj)
#pragma unroll
                    for (int n = 0; n < 2; ++n) { const f32x4 xs = *(const f32x4*)(xres + off + bj * HALF + n * 16); *(f32x4*)(out + off + bj * HALF + n * 16) = xs * ALPHA + acc[ai][bj][m][n]; } }
    }
};
struct EpiGate {
    static constexpr bool PERM = false;
    float* x; bf16_t* ppx; const float* bg;
    __device__ __forceinline__ void operator()(const f32x4 (&acc)[2][2][4][2], const Unit& u, int wr, int wc, int fr_, int fq_) const {
        int t_ = lane_opq(); const int fr = t_ & 15, fq = (t_ >> 4) & 3; (void)fr_; (void)fq_;
        const int col0 = u.pn * BM + wc * 32 + 4 * fq;
#pragma unroll
        for (int bj = 0; bj < 2; ++bj)
#pragma unroll
            for (int n = 0; n < 2; ++n) { const f32x4 bv = *(const f32x4*)(bg + col0 + bj * HALF + n * 16);
#pragma unroll
                for (int ai = 0; ai < 2; ++ai)
#pragma unroll
                    for (int m = 0; m < 4; ++m) { const size_t off = (size_t)(u.pm * BM + ai * HALF + wr * 64 + m * 16 + fr) * D + col0 + bj * HALF + n * 16;
                        const f32x4 xs = *(const f32x4*)(x + off); const u32x2 pw = *(const u32x2*)(ppx + off);
                        const f32x4 z = acc[ai][bj][m][n] + bv; f32x4 o;
                        o[0] = xs[0] + bflo(pw.x) / (1.f + __expf(-z[0])); o[1] = xs[1] + bfhi(pw.x) / (1.f + __expf(-z[1]));
                        o[2] = xs[2] + bflo(pw.y) / (1.f + __expf(-z[2])); o[3] = xs[3] + bfhi(pw.y) / (1.f + __expf(-z[3]));
                        *(f32x4*)(x + off) = o; u32x2 w; w.x = pk2(o[0], o[1]); w.y = pk2(o[2], o[3]); *(u32x2*)(ppx + off) = w;
                        if (m & 1) asm volatile("" ::: "memory"); } }
    }
};


__device__ __forceinline__ void row_stats(const long long* st, int row, float& mu, float& rs) {
    const i64x2 v = *(const i64x2*)(st + 2 * (size_t)row); const float s1 = (float)((double)v.x * FIX_INV), s2 = (float)((double)v.y * FIX_INV);
    mu = s1 * (1.f / D); const float var = fmaxf(s2 * (1.f / D) - mu * mu, 0.f); rs = 1.f / sqrtf(var + LN_EPS);
}
__device__ __forceinline__ void unpack8(const u32x4 w, f32x4& lo, f32x4& hi) { lo[0] = bflo(w.x); lo[1] = bfhi(w.x); lo[2] = bflo(w.y); lo[3] = bfhi(w.y); hi[0] = bflo(w.z); hi[1] = bfhi(w.z); hi[2] = bflo(w.w); hi[3] = bfhi(w.w); }
template <bool LNIN> struct EpiResidStats {
    static constexpr bool PERM = true;
    bf16_t* yb; long long* st_out; const long long* st_in; const float* g; const float* b;
    __device__ __forceinline__ void operator()(const f32x4 (&acc)[2][2][4][2], const Unit& u, int wr, int wc, int fr_, int fq_) const {
        int t_ = lane_opq(); const int fr = t_ & 15, fq = (t_ >> 4) & 3; (void)fr_; (void)fq_;
        const int col0 = u.pn * BM + wc * 32 + 8 * fq, rowb = u.pm * BM + wr * 64 + fr;
        float sm[2][4], sq[2][4], mu[2][4], rs[2][4];
#pragma unroll
        for (int ai = 0; ai < 2; ++ai)
#pragma unroll
            for (int m = 0; m < 4; ++m) { sm[ai][m] = 0.f; sq[ai][m] = 0.f; mu[ai][m] = 0.f; rs[ai][m] = 1.f; if (LNIN) row_stats(st_in, rowb + ai * HALF + m * 16, mu[ai][m], rs[ai][m]); }
#pragma unroll
        for (int bj = 0; bj < 2; ++bj) { const int c = col0 + bj * HALF;
            f32x4 g0 = {1.f, 1.f, 1.f, 1.f}, g1 = g0, b0 = {0.f, 0.f, 0.f, 0.f}, b1 = b0;
            if (LNIN) { g0 = *(const f32x4*)(g + c); g1 = *(const f32x4*)(g + c + 4); b0 = *(const f32x4*)(b + c); b1 = *(const f32x4*)(b + c + 4); }
            u32x4 ld[2][4];
#pragma unroll
            for (int ai = 0; ai < 2; ++ai)
#pragma unroll
                for (int m = 0; m < 4; ++m) ld[ai][m] = ldg<u32x4>(yb, ((unsigned)(rowb + ai * HALF + m * 16) * D + (unsigned)c) * 2u);
#pragma unroll
            for (int ai = 0; ai < 2; ++ai)
#pragma unroll
                for (int m = 0; m < 4; ++m) { const unsigned off2 = ((unsigned)(rowb + ai * HALF + m * 16) * D + (unsigned)c) * 2u;
                    f32x4 x0, x1; unpack8(ld[ai][m], x0, x1);
                    if (LNIN) { x0 = (x0 - mu[ai][m]) * rs[ai][m] * g0 + b0; x1 = (x1 - mu[ai][m]) * rs[ai][m] * g1 + b1; }
                    const f32x4 y0 = x0 * ALPHA + acc[ai][bj][m][0], y1 = x1 * ALPHA + acc[ai][bj][m][1];
                    u32x4 w; w.x = pk2(y0[0], y0[1]); w.y = pk2(y0[2], y0[3]); w.z = pk2(y1[0], y1[1]); w.w = pk2(y1[2], y1[3]); stg<u32x4>(yb, off2, w);
                    sm[ai][m] += ((y0[0] + y0[1]) + (y0[2] + y0[3])) + ((y1[0] + y1[1]) + (y1[2] + y1[3]));
                    sq[ai][m] += ((y0[0] * y0[0] + y0[1] * y0[1]) + (y0[2] * y0[2] + y0[3] * y0[3])) + ((y1[0] * y1[0] + y1[1] * y1[1]) + (y1[2] * y1[2] + y1[3] * y1[3])); }
            asm volatile("" ::: "memory"); }
#pragma unroll
        for (int ai = 0; ai < 2; ++ai)
#pragma unroll
            for (int m = 0; m < 4; ++m) { float a = sm[ai][m], q = sq[ai][m];
                a += shx(a, t_, 16); a += shx(a, t_, 32); q += shx(q, t_, 16); q += shx(q, t_, 32);
                if (fq == 0) { long long* p = st_out + 2 * (size_t)(rowb + ai * HALF + m * 16); fix_add(p, a); fix_add(p + 1, q); } }
    }
};
struct EpiUpLN {
    static constexpr bool PERM = true;
    bf16_t* O; int ldc; const long long* st_in; const float* cs; const float* bv;
    __device__ __forceinline__ void operator()(const f32x4 (&acc)[2][2][4][2], const Unit& u, int wr, int wc, int fr_, int fq_) const {
        int t_ = lane_opq(); const int fr = t_ & 15, fq = (t_ >> 4) & 3; (void)fr_; (void)fq_;
        const int row0 = u.pm * BM + wr * 64 + fr, col0 = u.pn * BM + wc * 32 + 8 * fq;
        f32x4 csv[2][2], bvv[2][2];
#pragma unroll
        for (int bj = 0; bj < 2; ++bj)
#pragma unroll
            for (int n = 0; n < 2; ++n) { csv[bj][n] = *(const f32x4*)(cs + col0 + bj * HALF + 4 * n); bvv[bj][n] = *(const f32x4*)(bv + col0 + bj * HALF + 4 * n); }
        float muv[2][4], rsv[2][4];
        { i64x2 ls[2][4];
#pragma unroll
          for (int ai = 0; ai < 2; ++ai)
#pragma unroll
              for (int m = 0; m < 4; ++m) ls[ai][m] = *(const i64x2*)(st_in + 2 * (size_t)(row0 + ai * HALF + m * 16));
#pragma unroll
          for (int ai = 0; ai < 2; ++ai)
#pragma unroll
              for (int m = 0; m < 4; ++m) { const float s1_ = (float)((double)ls[ai][m].x * FIX_INV), s2_ = (float)((double)ls[ai][m].y * FIX_INV);
                  muv[ai][m] = s1_ * (1.f / D); rsv[ai][m] = 1.f / sqrtf(fmaxf(s2_ * (1.f / D) - muv[ai][m] * muv[ai][m], 0.f) + LN_EPS); } }
#pragma unroll
        for (int ai = 0; ai < 2; ++ai)
#pragma unroll
            for (int m = 0; m < 4; ++m) { const int row = row0 + ai * HALF + m * 16; const float mu = muv[ai][m], rs = rsv[ai][m]; bf16_t* rowp = O + (size_t)row * ldc + col0;
#pragma unroll
                for (int bj = 0; bj < 2; ++bj) { f32x4 v0 = (acc[ai][bj][m][0] - csv[bj][0] * mu) * rs + bvv[bj][0], v1 = (acc[ai][bj][m][1] - csv[bj][1] * mu) * rs + bvv[bj][1];
#pragma unroll
                    for (int e = 0; e < 4; ++e) { const float a = fmaxf(v0[e], 0.f), b = fmaxf(v1[e], 0.f); v0[e] = a * a; v1[e] = b * b; }
                    u32x4 w; w.x = pk2(v0[0], v0[1]); w.y = pk2(v0[2], v0[3]); w.z = pk2(v1[0], v1[1]); w.w = pk2(v1[2], v1[3]);
                    __builtin_nontemporal_store(w, (u32x4*)(rowp + bj * HALF)); } }
    }
};
struct EpiGateLN {
    static constexpr bool PERM = true;
    const bf16_t* y2b; bf16_t* ppx; float* outf; const long long* st_in; const float* g; const float* b; const float* cs; const float* bv; const float* bg;
    __device__ __forceinline__ void operator()(const f32x4 (&acc)[2][2][4][2], const Unit& u, int wr, int wc, int fr_, int fq_) const {
        int t_ = lane_opq(); const int fr = t_ & 15, fq = (t_ >> 4) & 3; (void)fr_; (void)fq_;
        const int col0 = u.pn * BM + wc * 32 + 8 * fq, rowb = u.pm * BM + wr * 64 + fr;
        float muv[2][4], rsv[2][4];
        { i64x2 ls[2][4];
#pragma unroll
          for (int ai = 0; ai < 2; ++ai)
#pragma unroll
              for (int m = 0; m < 4; ++m) ls[ai][m] = *(const i64x2*)(st_in + 2 * (size_t)(rowb + ai * HALF + m * 16));
#pragma unroll
          for (int ai = 0; ai < 2; ++ai)
#pragma unroll
              for (int m = 0; m < 4; ++m) { const float s1_ = (float)((double)ls[ai][m].x * FIX_INV), s2_ = (float)((double)ls[ai][m].y * FIX_INV);
                  muv[ai][m] = s1_ * (1.f / D); rsv[ai][m] = 1.f / sqrtf(fmaxf(s2_ * (1.f / D) - muv[ai][m] * muv[ai][m], 0.f) + LN_EPS); } }
#pragma unroll
        for (int bj = 0; bj < 2; ++bj) { const unsigned c = (unsigned)(col0 + bj * HALF), c4 = c * 4u;
            const f32x4 g0 = ldg<f32x4>(g, c4), g1 = ldg<f32x4>(g, c4 + 16), b0 = ldg<f32x4>(b, c4), b1 = ldg<f32x4>(b, c4 + 16);
            const f32x4 c0 = ldg<f32x4>(cs, c4), c1 = ldg<f32x4>(cs, c4 + 16);
            const f32x4 z0b = ldg<f32x4>(bv, c4) + ldg<f32x4>(bg, c4), z1b = ldg<f32x4>(bv, c4 + 16) + ldg<f32x4>(bg, c4 + 16);
#pragma unroll
            for (int ai = 0; ai < 2; ++ai)
#pragma unroll
                for (int m = 0; m < 4; ++m) { const int row = rowb + ai * HALF + m * 16; const unsigned off2 = ((unsigned)row * D + c) * 2u;
                    const float mu = muv[ai][m], rs = rsv[ai][m];
                    f32x4 x0, x1, p0, p1; unpack8(ldg<u32x4>(y2b, off2), x0, x1); unpack8(ldg<u32x4>(ppx, off2), p0, p1);
                    x0 = (x0 - mu) * rs * g0 + b0; x1 = (x1 - mu) * rs * g1 + b1;
                    const f32x4 z0 = (acc[ai][bj][m][0] - c0 * mu) * rs + z0b, z1 = (acc[ai][bj][m][1] - c1 * mu) * rs + z1b;
                    f32x4 o0, o1;
#pragma unroll
                    for (int e = 0; e < 4; ++e) { o0[e] = x0[e] + p0[e] / (1.f + __expf(-z0[e])); o1[e] = x1[e] + p1[e] / (1.f + __expf(-z1[e])); }
                    u32x4 w; w.x = pk2(o0[0], o0[1]); w.y = pk2(o0[2], o0[3]); w.z = pk2(o1[0], o1[1]); w.w = pk2(o1[2], o1[3]); if (outf) { stg<f32x4>(outf, off2 * 2u, o0); stg<f32x4>(outf, off2 * 2u + 16, o1); } else stg<u32x4>(ppx, off2, w);
                    if (m & 1) asm volatile("" ::: "memory"); } }
    }
};

template <class Epi, bool ALIGN_EPI>
__device__ __forceinline__ void gemm_phase(LAS unsigned char* lds, const Gemm g, const StaticOrder& S, const Epi& E) {
    int wv_ = g.wave; asm volatile("" : "+s"(wv_));
    const int tid = wv_ * 64 + lane_opq();
    const int wid = wv_, lane = tid & 63, wr = wid >> 2, wc = wid & 3, fr = lane & 15, fq = lane >> 4;
    const int K = g.K, nt = K / BK, lda = g.lda;
    unsigned voffA[2], voffB[2];
#pragma unroll
    for (int i = 0; i < 2; ++i) { int R, C; stage_rc(tid * 16 + i * 8192, R, C); const int Rb = Epi::PERM ? ((R & ~31) + perm32(R & 31)) : R;
        voffA[i] = (unsigned)(R * lda + C) * 2u; voffB[i] = (unsigned)(Rb * K + C) * 2u; }
    const size_t kstep = (size_t)(BK * 2);
    const size_t hstepA = (size_t)HALF * lda * 2, hstepB = (size_t)HALF * K * 2;
    const size_t tstepA = 2 * hstepA, tstepB = 2 * hstepB;
    const unsigned ldsw = (unsigned)wid * 1024u;
    const int aoff = lds_byte(wr * 64 + fr, fq * 8), boff = lds_byte(wc * 32 + fr, fq * 8);
#define PG8_SA(b, h) (((b) * 2 + (h)) * HTB)
#define PG8_SB(b, h) ((4 + (b) * 2 + (h)) * HTB)
#define PG8_STAGE(bufoff, gbase, voff) do { _Pragma("unroll") for (int _i = 0; _i < 2; ++_i) \
        __builtin_amdgcn_global_load_lds((const unsigned*)((const char*)(gbase) + (voff)[_i]), (LAS unsigned*)(lds + (bufoff) + ldsw + _i * 8192), 16, 0, 0); } while (0)
#define PG8_LDA(dst, b, h) do { _Pragma("unroll") for (int m = 0; m < 4; ++m) _Pragma("unroll") for (int k = 0; k < 2; ++k) dst[m][k] = *(const LAS bf16x8*)(lds + PG8_SA(b, h) + aoff + m * 2048 + k * 1024); } while (0)
#define PG8_LDB(dst, b, h) do { _Pragma("unroll") for (int n = 0; n < 2; ++n) _Pragma("unroll") for (int k = 0; k < 2; ++k) dst[n][k] = *(const LAS bf16x8*)(lds + PG8_SB(b, h) + boff + n * 2048 + k * 1024); } while (0)
#define PG8_MMA(ai, bj, At, Bt) do { __builtin_amdgcn_s_setprio(1); _Pragma("unroll") for (int m = 0; m < 4; ++m) _Pragma("unroll") for (int n = 0; n < 2; ++n) _Pragma("unroll") for (int k = 0; k < 2; ++k) \
        acc[ai][bj][m][n] = __builtin_amdgcn_mfma_f32_16x16x32_bf16(Bt[n][k], At[m][k], acc[ai][bj][m][n], 0, 0, 0); __builtin_amdgcn_s_setprio(0); } while (0)
#define PG8_WAIT_V(n) asm volatile("s_waitcnt vmcnt(" #n ")" ::: "memory")
#define PG8_WAIT_L(n) asm volatile("s_waitcnt lgkmcnt(" #n ")" ::: "memory")
#define PG8_BAR __builtin_amdgcn_s_barrier()
#define PG8_SCHED __builtin_amdgcn_sched_barrier(0)
    Unit cur, nxt; int ui = 0;
    if (!S.next(0, cur)) return;
    f32x4 acc[2][2][4][2];
#pragma unroll
    for (int a = 0; a < 2; ++a)
#pragma unroll
        for (int b = 0; b < 2; ++b)
#pragma unroll
            for (int m = 0; m < 4; ++m)
#pragma unroll
                for (int n = 0; n < 2; ++n) acc[a][b][m][n] = (f32x4){0.f, 0.f, 0.f, 0.f};
    bf16x8 At[4][2], B0[2][2], B1[2][2];
    const char* cA = (const char*)g.A + (size_t)cur.pm * tstepA; const char* cB = (const char*)g.Bt + (size_t)cur.pn * tstepB;
    PG8_STAGE(PG8_SB(0, 0), cB, voffB); PG8_STAGE(PG8_SB(0, 1), cB + hstepB, voffB); PG8_STAGE(PG8_SA(0, 0), cA, voffA); PG8_STAGE(PG8_SA(0, 1), cA + hstepA, voffA);
    if (wr == 1) PG8_BAR;
    PG8_WAIT_V(2); PG8_BAR;
    PG8_STAGE(PG8_SB(1, 0), cB + kstep, voffB); PG8_STAGE(PG8_SA(1, 0), cA + kstep, voffA); PG8_STAGE(PG8_SB(1, 1), cB + hstepB + kstep, voffB);
    PG8_WAIT_V(6); PG8_BAR;
    for (;;) {
        const bool has_next = S.next(ui + 1, nxt);
        const char* nA = has_next ? (const char*)g.A + (size_t)nxt.pm * tstepA : cA; const char* nB = has_next ? (const char*)g.Bt + (size_t)nxt.pn * tstepB : cB;
        for (int t = 0; t < nt; t += 2) {
            const bool last = (t == nt - 2);
            const char* a1 = cA + (size_t)(t + 1) * kstep;
            const char* a2 = last ? nA : cA + (size_t)(t + 2) * kstep; const char* b2 = last ? nB : cB + (size_t)(t + 2) * kstep;
            const char* a3 = a2 + kstep; const char* b3 = b2 + kstep;
            PG8_LDB(B0, 0, 0); PG8_LDB(B1, 0, 1); PG8_SCHED; PG8_LDA(At, 0, 0); PG8_STAGE(PG8_SA(1, 1), a1 + hstepA, voffA);
            PG8_WAIT_V(8); PG8_WAIT_L(0); PG8_BAR; PG8_MMA(0, 0, At, B0); PG8_MMA(0, 1, At, B1); PG8_BAR; PG8_SCHED;
            PG8_LDA(At, 0, 1); PG8_STAGE(PG8_SB(0, 0), b2, voffB); PG8_STAGE(PG8_SB(0, 1), b2 + hstepB, voffB); PG8_STAGE(PG8_SA(0, 0), a2, voffA);
            PG8_WAIT_V(8); PG8_WAIT_L(0); PG8_BAR; PG8_MMA(1, 0, At, B0); PG8_MMA(1, 1, At, B1); PG8_BAR; PG8_SCHED;
            PG8_LDB(B0, 1, 0); PG8_LDB(B1, 1, 1); PG8_SCHED; PG8_LDA(At, 1, 0); PG8_STAGE(PG8_SA(0, 1), a2 + hstepA, voffA);
            PG8_WAIT_V(8); PG8_WAIT_L(0); PG8_BAR; PG8_MMA(0, 0, At, B0); PG8_MMA(0, 1, At, B1); PG8_BAR; PG8_SCHED;
            PG8_LDA(At, 1, 1); PG8_STAGE(PG8_SB(1, 0), b3, voffB); PG8_STAGE(PG8_SB(1, 1), b3 + hstepB, voffB); PG8_STAGE(PG8_SA(1, 0), a3, voffA);
            PG8_WAIT_V(8); PG8_WAIT_L(0); PG8_BAR; PG8_MMA(1, 0, At, B0); PG8_MMA(1, 1, At, B1); PG8_BAR; PG8_SCHED;
        }
        if constexpr (ALIGN_EPI) { if (wr == 0) PG8_BAR; }
        E(acc, cur, wr, wc, fr, fq);
        if (!has_next) break;
#pragma unroll
        for (int a = 0; a < 2; ++a)
#pragma unroll
            for (int b = 0; b < 2; ++b)
#pragma unroll
                for (int m = 0; m < 4; ++m)
#pragma unroll
                    for (int n = 0; n < 2; ++n) acc[a][b][m][n] = (f32x4){0.f, 0.f, 0.f, 0.f};
        cur = nxt; cA = nA; cB = nB; ++ui;
        if constexpr (ALIGN_EPI) { if (wr == 1) PG8_BAR; }
    }
    PG8_WAIT_V(0);
    if constexpr (!ALIGN_EPI) { if (wr == 0) PG8_BAR; }
    PG8_BAR;
#undef PG8_SA
#undef PG8_SB
#undef PG8_STAGE
#undef PG8_LDA
#undef PG8_LDB
#undef PG8_MMA
#undef PG8_WAIT_V
#undef PG8_WAIT_L
#undef PG8_BAR
#undef PG8_SCHED
}
}

namespace att {
constexpr int KBUFB = 13824, BOFF = 13312, VBASE = 2 * KBUFB, VBUFB = 9216, TABOFF = VBASE + 3 * VBUFB;
constexpr int VPB = 144;
__device__ __forceinline__ int crow(int r, int hi) { return (r & 3) + 8 * (r >> 2) + 4 * hi; }
struct Tens {
    const bf16_t* Q; int qpitch;
    const bf16_t* KA; int kpitch;
    const bf16_t* KB;
    const bf16_t* V; int vpitch;
    const float* kbias;
    bf16_t* O;
    float sink_l2; int wave;
};
template <int MODE>
__device__ __forceinline__ void unit(LAS unsigned char* lds, const Tens& T, int qb) {
    constexpr int DQK = (MODE == 0) ? 96 : 64, NDS = DQK / 16, KPB = (DQK + 8) * 2;
    int wv_ = T.wave; asm volatile("" : "+s"(wv_));
    const int tid = wv_ * 64 + lane_opq();
    const int lane = tid & 63, r32 = lane & 31, hi = lane >> 5, w = wv_;
    const int q0 = qb * 256, qw = q0 + 32 * w, qg = qw + r32;
    const int t_lo = (MODE == 2) ? (4 * qb - 2 > 0 ? 4 * qb - 2 : 0) : 0, t_hi = 4 * qb + 3;
    const bool lead = (w < 4);
    const int ka_row = tid >> 3, ka_ch = tid & 7, kb_row = (tid >> 2) & 63, kb_ch = tid & 3, v_kv = tid & 63, v_dc = tid >> 6;
    const int v_pos = (v_kv & ~12) | ((v_kv & 8) >> 1) | ((v_kv & 4) << 1);
    u32x4 rka_x, rkb_x = {0u, 0u, 0u, 0u}, rv_x, rka_y, rkb_y = {0u, 0u, 0u, 0u}, rv_y; float rbias_x = 0.f, rbias_y = 0.f;
#define ATT_LOAD(t, S) do { const int kv0_ = (t) * 64; \
        rka_##S = *(const u32x4*)(T.KA + (size_t)(kv0_ + ka_row) * T.kpitch + 8 * ka_ch); \
        if (MODE == 0) rkb_##S = *(const u32x4*)(T.KB + (size_t)(kv0_ + kb_row) * 32 + 8 * kb_ch); \
        rv_##S = *(const u32x4*)(T.V + (size_t)(kv0_ + v_kv) * T.vpitch + 8 * v_dc); \
        if (MODE == 1) rbias_##S = T.kbias[kv0_ + (tid & 63)]; } while (0)
#define ATT_STORE(kbuf, vbuf, S) do { LAS unsigned char* b_ = lds + (kbuf) * KBUFB; \
        *(LAS u32x4*)(b_ + ka_row * KPB + ka_ch * 16) = rka_##S; \
        if (MODE == 0 && tid < 256) *(LAS u32x4*)(b_ + kb_row * KPB + 128 + kb_ch * 16) = rkb_##S; \
        { LAS unsigned short* vt_ = (LAS unsigned short*)(lds + VBASE + (vbuf) * VBUFB) + (8 * v_dc) * (VPB / 2) + v_pos; \
          vt_[0 * (VPB / 2)] = (unsigned short)(rv_##S.x & 0xffffu); vt_[1 * (VPB / 2)] = (unsigned short)(rv_##S.x >> 16); \
          vt_[2 * (VPB / 2)] = (unsigned short)(rv_##S.y & 0xffffu); vt_[3 * (VPB / 2)] = (unsigned short)(rv_##S.y >> 16); \
          vt_[4 * (VPB / 2)] = (unsigned short)(rv_##S.z & 0xffffu); vt_[5 * (VPB / 2)] = (unsigned short)(rv_##S.z >> 16); \
          vt_[6 * (VPB / 2)] = (unsigned short)(rv_##S.w & 0xffffu); vt_[7 * (VPB / 2)] = (unsigned short)(rv_##S.w >> 16); } \
        if (MODE == 1 && tid < 64) *(LAS float*)(b_ + BOFF + 4 * tid) = rbias_##S; } while (0)
#define ATT_QK(kv0_, kbuf) do { const LAS unsigned char* kb_ = lds + (kbuf) * KBUFB; \
        if (MODE == 1) { const LAS float* bb = (const LAS float*)(kb_ + BOFF); \
            _Pragma("unroll") for (int g = 0; g < 4; ++g) { const f32x4 b0 = *(const LAS f32x4*)(bb + 8 * g + 4 * hi), b1 = *(const LAS f32x4*)(bb + 32 + 8 * g + 4 * hi); \
                _Pragma("unroll") for (int e = 0; e < 4; ++e) { s0[4 * g + e] = b0[e]; s1[4 * g + e] = b1[e]; } } \
        } else if (MODE == 2) { const LAS float* tab = (const LAS float*)(lds + TABOFF); \
            _Pragma("unroll") for (int r = 0; r < 16; ++r) { const int d0 = qg - ((kv0_) + crow(r, hi)); s0[r] = tab[d0 & 127]; s1[r] = tab[(d0 - 32) & 127]; } \
        } else { _Pragma("unroll") for (int r = 0; r < 16; ++r) { s0[r] = 0.f; s1[r] = 0.f; } } \
        __builtin_amdgcn_s_setprio(1);     \
        _Pragma("unroll") for (int ds = 0; ds < NDS; ++ds) { \
            const bf16x8 a0 = *(const LAS bf16x8*)(kb_ + r32 * KPB + ds * 32 + hi * 16); \
            const bf16x8 a1 = *(const LAS bf16x8*)(kb_ + (32 + r32) * KPB + ds * 32 + hi * 16); \
            s0 = __builtin_amdgcn_mfma_f32_32x32x16_bf16(a0, qf[ds], s0, 0, 0, 0); \
            s1 = __builtin_amdgcn_mfma_f32_32x32x16_bf16(a1, qf[ds], s1, 0, 0, 0); } \
        __builtin_amdgcn_s_setprio(0); } while (0)
#define MX3(a, b, c) __builtin_fmaxf(__builtin_fmaxf((a), (b)), (c))
#define ATT_SMPV(kv0_, vbuf) do { \
        if (MODE == 2) { \
            _Pragma("unroll") for (int r = 0; r < 16; ++r) { const int d0 = qg - ((kv0_) + crow(r, hi)), d1 = d0 - 32; \
                s0[r] = ((unsigned)d0 < 128u) ? s0[r] : -INFINITY; s1[r] = ((unsigned)d1 < 128u) ? s1[r] : -INFINITY; } \
        } else if ((kv0_) + 63 > qw) { \
            _Pragma("unroll") for (int r = 0; r < 16; ++r) { const int kv = (kv0_) + crow(r, hi); if (kv > qg) s0[r] = -INFINITY; if (kv + 32 > qg) s1[r] = -INFINITY; } \
        } \
        float ra = MX3(s0[0], s0[1], s1[0]), rb = MX3(s0[2], s0[3], s1[1]); ra = MX3(ra, s1[2], s1[3]); \
        _Pragma("unroll") for (int r = 4; r < 16; r += 4) { ra = MX3(ra, s0[r], s0[r + 1]); rb = MX3(rb, s0[r + 2], s0[r + 3]); ra = MX3(ra, s1[r], s1[r + 1]); rb = MX3(rb, s1[r + 2], s1[r + 3]); } \
        float rm = fmaxf(ra, rb); { auto rr_ = __builtin_amdgcn_permlane32_swap(__float_as_uint(rm), __float_as_uint(rm), false, false); rm = fmaxf(__uint_as_float(rr_[0]), __uint_as_float(rr_[1])); } \
          \
        if (__any(rm > mrun + 16.f)) { const float mnew = fmaxf(mrun, rm), alpha = __builtin_amdgcn_exp2f(mrun - mnew); mrun = mnew; lrun *= alpha; \
            _Pragma("unroll") for (int r = 0; r < 16; ++r) { o0[r] *= alpha; o1[r] *= alpha; } } \
        f32x2_t acc2 = {0.f, 0.f}; const f32x2_t m2 = {mrun, mrun}; \
        _Pragma("unroll") for (int r = 0; r < 16; r += 2) { \
            f32x2_t a = {s0[r], s0[r + 1]}, b = {s1[r], s1[r + 1]}; a = a - m2; b = b - m2; \
            a.x = __builtin_amdgcn_exp2f(a.x); a.y = __builtin_amdgcn_exp2f(a.y); b.x = __builtin_amdgcn_exp2f(b.x); b.y = __builtin_amdgcn_exp2f(b.y); \
            s0[r] = a.x; s0[r + 1] = a.y; s1[r] = b.x; s1[r + 1] = b.y; acc2 = acc2 + a; acc2 = acc2 + b; } \
        lrun += acc2.x + acc2.y; \
        bf16x8 pf[4]; \
        _Pragma("unroll") for (int j = 0; j < 4; ++j) { u32x4 p_; \
            if (j < 2) { p_.x = pk2(s0[8 * j + 0], s0[8 * j + 1]); p_.y = pk2(s0[8 * j + 2], s0[8 * j + 3]); p_.z = pk2(s0[8 * j + 4], s0[8 * j + 5]); p_.w = pk2(s0[8 * j + 6], s0[8 * j + 7]); } \
            else { const int jj = j - 2; p_.x = pk2(s1[8 * jj + 0], s1[8 * jj + 1]); p_.y = pk2(s1[8 * jj + 2], s1[8 * jj + 3]); p_.z = pk2(s1[8 * jj + 4], s1[8 * jj + 5]); p_.w = pk2(s1[8 * jj + 6], s1[8 * jj + 7]); } \
            pf[j] = __builtin_bit_cast(bf16x8, p_); } \
        const LAS unsigned char* vb_ = lds + VBASE + (vbuf) * VBUFB; \
        _Pragma("unroll") for (int j = 0; j < 4; ++j) { \
            const bf16x8 v0 = *(const LAS bf16x8*)(vb_ + r32 * VPB + j * 32 + hi * 16); \
            const bf16x8 v1 = *(const LAS bf16x8*)(vb_ + (32 + r32) * VPB + j * 32 + hi * 16); \
            o0 = __builtin_amdgcn_mfma_f32_32x32x16_bf16(v0, pf[j], o0, 0, 0, 0); \
            o1 = __builtin_amdgcn_mfma_f32_32x32x16_bf16(v1, pf[j], o1, 0, 0, 0); } } while (0)
#define ATT_PART(kv0_) (((kv0_) <= qw + 31) && (MODE != 2 || (kv0_) + 63 >= qw - 127))
    ATT_LOAD(t_lo, x);
    bf16x8 qf[NDS];
#pragma unroll
    for (int ds = 0; ds < NDS; ++ds) qf[ds] = *(const bf16x8*)(T.Q + (size_t)qg * T.qpitch + 16 * ds + 8 * hi);
    if (MODE == 2 && tid < 128) *(LAS float*)(lds + TABOFF + 4 * tid) = T.kbias[tid];
    ATT_STORE(0, 0, x);
    ATT_LOAD(t_lo + 1, x);
    __syncthreads();
    float mrun = (MODE == 2) ? T.sink_l2 : -INFINITY, lrun = (MODE == 2) ? (hi == 0 ? 1.f : 0.f) : 0.f;
    f32x16 o0, o1, s0, s1;
#pragma unroll
    for (int r = 0; r < 16; ++r) { o0[r] = 0.f; o1[r] = 0.f; s0[r] = 0.f; s1[r] = 0.f; }
    int kcur = 0, vcur = 0, vprev = 0;
    bool pend = false;
#define ATT_HALF(tt, SL, SS) do { const int kv0 = (tt) * 64, vnext = (vcur == 2) ? 0 : vcur + 1; \
        ATT_LOAD(((tt) + 2 <= t_hi) ? (tt) + 2 : t_hi, SL);     \
        if (lead) { if (ATT_PART(kv0)) { ATT_QK(kv0, kcur); ATT_SMPV(kv0, vcur); } } \
        else { if (pend) { ATT_SMPV(kv0 - 64, vprev); } pend = ATT_PART(kv0); if (pend) { ATT_QK(kv0, kcur); } } \
        if ((tt) + 1 <= t_hi) ATT_STORE(kcur ^ 1, vnext, SS); \
        __syncthreads(); \
        vprev = vcur; vcur = vnext; kcur ^= 1; } while (0)
    for (int t = t_lo; t <= t_hi; t += 2) { ATT_HALF(t, y, x); ATT_HALF(t + 1, x, y); }
#undef ATT_HALF
    if (!lead && pend) { ATT_SMPV(t_hi * 64, vprev); }
    float ltot; { auto rr_ = __builtin_amdgcn_permlane32_swap(__float_as_uint(lrun), __float_as_uint(lrun), false, false); ltot = __uint_as_float(rr_[0]) + __uint_as_float(rr_[1]); }
    const float inv = 1.f / ltot;
    { LAS unsigned char* stg_ = lds + 65536 + w * 4608;
#pragma unroll
      for (int g = 0; g < 4; ++g) {
          u32x2 w0, w1;
          w0.x = pk2(o0[4 * g + 0] * inv, o0[4 * g + 1] * inv); w0.y = pk2(o0[4 * g + 2] * inv, o0[4 * g + 3] * inv);
          w1.x = pk2(o1[4 * g + 0] * inv, o1[4 * g + 1] * inv); w1.y = pk2(o1[4 * g + 2] * inv, o1[4 * g + 3] * inv);
          *(LAS u32x2*)(stg_ + r32 * 144 + (8 * g + 4 * hi) * 2) = w0; *(LAS u32x2*)(stg_ + r32 * 144 + (32 + 8 * g + 4 * hi) * 2) = w1;
      }
      LDS_WAIT();
      bf16_t* obase = T.O + (size_t)qw * D;
#pragma unroll
      for (int i = 0; i < 4; ++i) { const int row = i * 8 + (lane >> 3), chk = lane & 7;
          const u32x4 v = *(const LAS u32x4*)(stg_ + row * 144 + chk * 16); *(u32x4*)(obase + (size_t)row * D + chk * 8) = v; }
    }
    __syncthreads();
#undef ATT_LOAD
#undef ATT_STORE
#undef ATT_QK
#undef ATT_SMPV
#undef ATT_PART
#undef MX3
}
}

struct Params {
    const float* x; const float* p; const float* rel_bias;
    const float* ev_w_in; const float* ev_q_norm; const float* ev_w_uq; const float* ev_kv_norm; const float* ev_w_ukv; const float* ev_sinks; const float* ev_w_out;
    const float* od_w_in; const float* od_b_f; const float* od_w_out;
    const float* ln1_g; const float* ln1_b; const float* w_up; const float* w_down; const float* ln2_g; const float* ln2_b;
    const float* ple_w_proj; const float* ple_w_gate; const float* ple_b_gate;
    float* out; unsigned char* ws;
};

__device__ __forceinline__ void prep_w(const float* W, int K, int ldw, int Nvalid, int Npad, bf16_t* WT, const float* kscale, LAS float* scr, int gw, int NGW, int lane,
                                       const float* kbias = nullptr, long long* cs_out = nullptr, long long* bv_out = nullptr) {
    const int nblk = Npad / 32, items = (K / 64) * nblk;
    for (int it = gw; it < items; it += NGW) {
        const int kb = it / nblk, nb = it % nblk, k0 = 64 * kb, n0 = 32 * nb;
        f32x4 csum = {0.f, 0.f, 0.f, 0.f}, bsum = {0.f, 0.f, 0.f, 0.f};
        const int c4 = (lane & 7) * 4, nn = n0 + c4;
#pragma unroll
        for (int i = 0; i < 8; ++i) { const int kk = 8 * i + (lane >> 3);
            f32x4 w = {0.f, 0.f, 0.f, 0.f}; if (nn < Nvalid) w = __builtin_nontemporal_load((const f32x4*)(W + (size_t)(k0 + kk) * ldw + nn));
            f32x4 v = w; if (kscale) v = v * kscale[k0 + kk];
            scr[kk * 33 + c4 + 0] = v[0]; scr[kk * 33 + c4 + 1] = v[1]; scr[kk * 33 + c4 + 2] = v[2]; scr[kk * 33 + c4 + 3] = v[3];
            if (cs_out) { const float kb_ = kbias[k0 + kk]; csum[0] += bflo(pk2(v[0], 0.f)); csum[1] += bflo(pk2(v[1], 0.f)); csum[2] += bflo(pk2(v[2], 0.f)); csum[3] += bflo(pk2(v[3], 0.f)); bsum = bsum + w * kb_; } }
        if (cs_out) {
#pragma unroll
            for (int e = 0; e < 4; ++e) { float a = csum[e], q = bsum[e];
                a += __shfl_xor(a, 8); a += __shfl_xor(a, 16); a += __shfl_xor(a, 32); q += __shfl_xor(q, 8); q += __shfl_xor(q, 16); q += __shfl_xor(q, 32);
                if (lane < 8) { pg8::fix_add(cs_out + nn + e, a); pg8::fix_add(bv_out + nn + e, q); } } }
        LDS_WAIT();
        const int c = lane & 7;
#pragma unroll
        for (int j = 0; j < 4; ++j) { const int n = (lane >> 3) + 8 * j; const LAS float* sp = scr + (8 * c) * 33 + n;
            u32x4 o; o.x = pk2(sp[0 * 33], sp[1 * 33]); o.y = pk2(sp[2 * 33], sp[3 * 33]); o.z = pk2(sp[4 * 33], sp[5 * 33]); o.w = pk2(sp[6 * 33], sp[7 * 33]);
            *(u32x4*)(WT + (size_t)(n0 + n) * K + k0 + 8 * c) = o; }
        LDS_WAIT();
    }
}
__device__ __forceinline__ void cvt_bf16(const float* src, bf16_t* dst, size_t n8, size_t gtid, size_t nthr) {
    size_t i = gtid;
    for (; i + 3 * nthr < n8; i += 4 * nthr) {
        f32x4 a[4], b[4];
#pragma unroll
        for (int u = 0; u < 4; ++u) { a[u] = __builtin_nontemporal_load((const f32x4*)(src + 8 * (i + u * nthr))); b[u] = __builtin_nontemporal_load((const f32x4*)(src + 8 * (i + u * nthr) + 4));     }
#pragma unroll
        for (int u = 0; u < 4; ++u) { u32x4 o; o.x = pk2(a[u][0], a[u][1]); o.y = pk2(a[u][2], a[u][3]); o.z = pk2(b[u][0], b[u][1]); o.w = pk2(b[u][2], b[u][3]); *(u32x4*)(dst + 8 * (i + u * nthr)) = o; }
    }
    for (; i < n8; i += nthr) { const f32x4 a = *(const f32x4*)(src + 8 * i), b = *(const f32x4*)(src + 8 * i + 4);
        u32x4 o; o.x = pk2(a[0], a[1]); o.y = pk2(a[2], a[3]); o.z = pk2(b[0], b[1]); o.w = pk2(b[2], b[3]); *(u32x4*)(dst + 8 * i) = o; }
}
__device__ __forceinline__ void ln_pass(float* R, bf16_t* XB, const float* g, const float* b, int gw, int NGW, int lane) {
    asm volatile("" : "+v"(lane));
    f32x4 gv[4], bv[4];
#pragma unroll
    for (int j = 0; j < 4; ++j) { gv[j] = *(const f32x4*)(g + 4 * lane + 256 * j); bv[j] = *(const f32x4*)(b + 4 * lane + 256 * j); }
    for (int row = gw; row < M; row += NGW) {
        float* xr = R + (size_t)row * D + 4 * lane;
        f32x4 v[4]; float s = 0.f;
#pragma unroll
        for (int j = 0; j < 4; ++j) { v[j] = *(const f32x4*)(xr + 256 * j); s += (v[j][0] + v[j][1]) + (v[j][2] + v[j][3]); }
        const float mean = wave_sum(s, lane) * (1.f / D); float s2 = 0.f;
#pragma unroll
        for (int j = 0; j < 4; ++j) { v[j] = v[j] - mean; s2 += (v[j][0] * v[j][0] + v[j][1] * v[j][1]) + (v[j][2] * v[j][2] + v[j][3] * v[j][3]); }
        const float rstd = 1.f / sqrtf(wave_sum(s2, lane) * (1.f / D) + LN_EPS);
        bf16_t* xb = XB + (size_t)row * D + 4 * lane;
#pragma unroll
        for (int j = 0; j < 4; ++j) { const f32x4 o = v[j] * rstd * gv[j] + bv[j]; *(f32x4*)(xr + 256 * j) = o; u32x2 w; w.x = pk2(o[0], o[1]); w.y = pk2(o[2], o[3]); *(u32x2*)(xb + 256 * j) = w; }
    }
}


#define XB_TMO      128
#define XB_XCNT(j)  (256  + 64 * (j))
#define XB_XSUB(j)  (1280 + 64 * (j))
#define XB_XGEN(j)  (2304 + 64 * (j))
#define XB_TOP      3328
#define XB_TOPGEN   3392
#define XCD_BAR_WORDS 3456
#define XB_SPIN_CAP (1u << 20)
__device__ __forceinline__ unsigned xb_ld(unsigned* p)              { return __hip_atomic_load(p, __ATOMIC_RELAXED, __HIP_MEMORY_SCOPE_AGENT); }
__device__ __forceinline__ unsigned xb_add(unsigned* p, unsigned v) { return __hip_atomic_fetch_add(p, v, __ATOMIC_RELAXED, __HIP_MEMORY_SCOPE_AGENT); }
__device__ __forceinline__ unsigned xb_xcc_id() { return (unsigned)__builtin_amdgcn_s_getreg((3 << 11) | 20) & 0xFu; }
#define XB_SPIN(cond, bar) do { unsigned _sp = 0; while (cond) { __builtin_amdgcn_s_sleep(1); \
    if ((++_sp & 255u) == 0u) { if (xb_ld(&(bar)[XB_TMO])) break; if (_sp > XB_SPIN_CAP) { atomicAdd(&(bar)[XB_TMO], 1u); break; } } } } while (0)
struct XcdBarrier { unsigned* bar; unsigned x; volatile LAS unsigned* st; };
__device__ __forceinline__ void xcd_barrier_complete(unsigned* bar, unsigned x, unsigned& nloc, unsigned& nx) {
    const unsigned G = gridDim.x * gridDim.y * gridDim.z;
    unsigned sum, cnt, mine, sp = 0u;
    for (;;) {
        sum = 0u; cnt = 0u; mine = 0u;
#pragma unroll
        for (unsigned j = 0; j < 16; ++j) { const unsigned c = xb_ld(&bar[XB_XCNT(j)]); sum += c; cnt += (c > 0u) ? 1u : 0u; mine = (j == x) ? c : mine; }
        if (sum == G) break;
        __builtin_amdgcn_s_sleep(1);
        if ((++sp & 255u) == 0u) { if (xb_ld(&bar[XB_TMO])) break; if (sp > XB_SPIN_CAP) { atomicAdd(&bar[XB_TMO], 1u); break; } }
    }
    nloc = mine > 0u ? mine : 1u; nx = cnt > 0u ? cnt : 1u;
}
__device__ __forceinline__ void xcd_barrier(const XcdBarrier& b, int tid) {
    asm volatile("s_waitcnt vmcnt(0)" ::: "memory");
    __syncthreads();
    if (tid == 0) {
        unsigned* bar = b.bar;
        __builtin_amdgcn_s_waitcnt(0);
        unsigned nloc = b.st[0], nx = b.st[1];
        if (nloc == 0u) { xcd_barrier_complete(bar, b.x, nloc, nx); b.st[0] = nloc; b.st[1] = nx; }
        const unsigned old = xb_add(&bar[XB_XSUB(b.x)], 1u);
        const unsigned gen = old / nloc;
        if (old + 1u == (gen + 1u) * nloc) {
            __builtin_amdgcn_fence(__ATOMIC_RELEASE, "agent");
            asm volatile("s_waitcnt vmcnt(0)" ::: "memory");
            const unsigned og = xb_add(&bar[XB_TOP], 1u);
            const unsigned tg = og / nx;
            if (og + 1u == (tg + 1u) * nx) xb_add(&bar[XB_TOPGEN], 1u);
            else XB_SPIN(xb_ld(&bar[XB_TOPGEN]) == tg, bar);
            __builtin_amdgcn_fence(__ATOMIC_ACQUIRE, "agent");
            xb_add(&bar[XB_XGEN(b.x)], 1u);
            asm volatile("s_waitcnt vmcnt(0)" ::: "memory");
        } else {
            XB_SPIN(xb_ld(&bar[XB_XGEN(b.x)]) == gen, bar);
            __builtin_amdgcn_fence(__ATOMIC_ACQUIRE, "agent");
            asm volatile("s_waitcnt vmcnt(0)" ::: "memory");
        }
    }
    __syncthreads();
}

constexpr int LDS_BYTES = 147456, XB_LDS_OFF = 140000;
__global__ void __launch_bounds__(NTHREADS, 2) fwd_megakernel(Params P) {
    extern __shared__ __attribute__((aligned(16))) unsigned char lds_raw[];
    cg::grid_group grid = cg::this_grid();
    LAS unsigned char* lds = (LAS unsigned char*)lds_raw;
    const int G = gridDim.x, bx = blockIdx.x;
    const int wave_s = __builtin_amdgcn_readfirstlane((int)threadIdx.x >> 6);
    const int vcu = (G % 8 == 0) ? (bx % 8) * (G / 8) + bx / 8 : bx;
    const int NGW = G * NWAVES;
#define PHASE_IDS const int tid = wave_s * 64 + lane_opq(); const int lane = tid & 63, wave = wave_s, gw = vcu * NWAVES + wave; (void)lane; (void)gw;
#define PHASE_GTID const size_t gtid = (size_t)bx * NTHREADS + tid, nthr = (size_t)G * NTHREADS;
#define KPDECL const __attribute__((address_space(4))) Params* kp = (const __attribute__((address_space(4))) Params*)__builtin_amdgcn_kernarg_segment_ptr(); asm volatile("" : "+s"(kp)); unsigned char* ws = kp->ws; (void)ws;
#define cosT ((float*)(ws + WS_COS))
#define sinT ((float*)(ws + WS_SIN))
#define biasT ((float*)(ws + WS_BIAST))
#define rstdq ((float*)(ws + WS_RSTDQ))
#define rstdkv ((float*)(ws + WS_RSTDKV))
#define lf ((float*)(ws + WS_LF))
#define ck ((float*)(ws + WS_CK))
#define KR ((bf16_t*)(ws + WS_KR))
#define WB ((bf16_t*)(ws + WS_W))
#define PB ((bf16_t*)(ws + WS_PB))
#define ST1 ((long long*)(ws + WS_ST1))
#define ST2 ((long long*)(ws + WS_ST2))
#define VEC ((float*)(ws + WS_VEC) + layer * VEC_LAYER)
#define ACT (ws + WS_ACT)
#define R (kp->out)
#define XB ((bf16_t*)(ws + ((layer & 1) ? WS_XB1 : WS_XB0)))
#define XN ((bf16_t*)(ws + ((layer & 1) ? WS_XB0 : WS_XB1)))
#define wcom (WB + W_COM0 + layer * WC_SZ)
#define we (WB + W_EVEN0 + j * WE_SZ)
#define wo (WB + W_ODD0 + j * WO_SZ)
#define BUF_H ((bf16_t*)(ACT + ACT_H))
#define BUF_Q ((bf16_t*)(ACT + ACT_Q))
#define BUF_KV ((bf16_t*)(ACT + ACT_KV))
#define w_out_t (even ? (const bf16_t*)(we + WE_OUT) : (const bf16_t*)(wo + WO_OUT))
#if PROBE
#define ts_ ((unsigned long long*)(ws + WS_RSTDQ + 768 * 1024))
#define tcat_ ((int*)(ws + WS_RSTDQ + 800 * 1024))
    int si_ = 0;
#define STAMP(cat) do { if (bx == 0 && threadIdx.x == 0) { KPDECL ts_[si_] = __builtin_amdgcn_s_memrealtime(); tcat_[si_] = (cat); } ++si_; } while (0)
#else
#define STAMP(cat) do { } while (0)
#endif
    STAMP(0);
    if (threadIdx.x < 2) ((volatile LAS unsigned*)(lds + XB_LDS_OFF))[threadIdx.x] = 0u;
    __syncthreads();
    { KPDECL if (threadIdx.x == 0) (void)xb_add(&((unsigned*)(ws + WS_BAR))[XB_XCNT(xb_xcc_id())], 1u); }
#define GRID_BAR() do { KPDECL XcdBarrier xb_; xb_.bar = (unsigned*)(ws + WS_BAR); xb_.x = xb_xcc_id(); xb_.st = (volatile LAS unsigned*)(lds + XB_LDS_OFF); xcd_barrier(xb_, wave_s * 64 + lane_opq()); } while (0)

    {
        KPDECL PHASE_IDS PHASE_GTID
        LAS float* scr = (LAS float*)(lds + wave * 16384);
        for (int j = 0; j < 2; ++j) {
            prep_w(kp->ev_w_in + (size_t)j * D * EIN, D, EIN, EIN, EINP, we + WE_IN, nullptr, scr, gw, NGW, lane);
            prep_w(kp->ev_w_uq + (size_t)j * 384 * 768, 384, 768, 768, 768, we + WE_UQ, kp->ev_q_norm + j * 384, scr, gw, NGW, lane);
            prep_w(kp->ev_w_ukv + (size_t)j * 256 * 1024, 256, 1024, 1024, 1024, we + WE_UKV, kp->ev_kv_norm + j * 256, scr, gw, NGW, lane);
            prep_w(kp->ev_w_out + (size_t)j * D * D, D, D, D, D, we + WE_OUT, nullptr, scr, gw, NGW, lane);
            prep_w(kp->od_w_in + (size_t)j * D * OIN, D, OIN, OIN, OINP, wo + WO_IN, nullptr, scr, gw, NGW, lane);
            prep_w(kp->od_w_out + (size_t)j * D * D, D, D, D, D, wo + WO_OUT, nullptr, scr, gw, NGW, lane);
        }
        for (int i = 0; i < DEPTH; ++i) {
            bf16_t* wc = WB + W_COM0 + i * WC_SZ;
            long long* vec = (long long*)(ws + WS_VECI) + i * VEC_LAYER;
            prep_w(kp->w_up + (size_t)i * D * FF, D, FF, FF, FF, wc + WC_UP, kp->ln1_g + i * D, scr, gw, NGW, lane, kp->ln1_b + i * D, vec, vec + 4096);
            prep_w(kp->w_down + (size_t)i * FF * D, FF, D, D, D, wc + WC_DOWN, nullptr, scr, gw, NGW, lane);
            prep_w(kp->ple_w_gate + (size_t)i * D * D, D, D, D, D, wc + WC_G, kp->ln2_g + i * D, scr, gw, NGW, lane, kp->ln2_b + i * D, vec + 8192, vec + 9216);
            prep_w(kp->ple_w_proj + (size_t)i * DPLE * D, DPLE, D, D, D, wc + WC_P, nullptr, scr, gw, NGW, lane);
        }
        cvt_bf16(kp->x, (bf16_t*)(ws + WS_XB0), (size_t)M * D / 8, gtid, nthr);
        for (size_t i = gtid; i < (size_t)2 * M; i += nthr) *(f32x4*)((float*)(ws + WS_SQ) + 4 * i) = (f32x4){0.f, 0.f, 0.f, 0.f};
        if (gtid < (size_t)SEQ * 16) { const int pos = (int)gtid >> 4, i = (int)gtid & 15;
            const float inv = 1.0f / powf(10000.0f, (float)i * (1.0f / 16.0f)); const float ang = (float)pos * inv;
            cosT[gtid] = cosf(ang); sinT[gtid] = sinf(ang); }
        if (gtid < 8 * 128) { const int h = (int)gtid >> 7, d = (int)gtid & 127; int bkt;
            if (d < 16) bkt = d; else { const float t = logf((float)d / 16.0f) / 2.0794415416798357f * 16.0f; bkt = 16 + (int)t; if (bkt > 31) bkt = 31; }
            biasT[gtid] = kp->rel_bias[bkt * 8 + h] * LOG2E; }
    }
    grid.sync(); STAMP(3);

    for (int layer = 0; layer < DEPTH; ++layer) {
        const int j = layer >> 1; const bool even = (layer & 1) == 0;
        { KPDECL PHASE_IDS PHASE_GTID
          float zf = 0.f; asm volatile("" : "+v"(zf)); const f32x4 z4 = {zf, zf, zf, zf};
          for (size_t i = gtid; i < (size_t)M; i += nthr) { *(f32x4*)((float*)ST1 + 4 * i) = z4; *(f32x4*)((float*)ST2 + 4 * i) = z4; }
          if (gtid < VEC_LAYER) VEC[gtid] = (float)((double)((const long long*)(ws + WS_VECI) + layer * VEC_LAYER)[gtid] * pg8::FIX_INV);
          cvt_bf16(kp->p + (size_t)layer * M * DPLE, PB, (size_t)M * DPLE / 8, gtid, nthr); }
        if (even) {
            { KPDECL pg8::Gemm g{XB, we + WE_IN, M, EINP, D, D, wave_s}; pg8::StaticOrder S; S.init(M, EINP, G, bx);
              pg8::EpiEvenIn E{BUF_H, (long long*)(ws + WS_SQ) + (size_t)j * 2 * M, KR, cosT, sinT, 0.125f * LOG2E}; pg8::gemm_phase<pg8::EpiEvenIn, true>(lds, g, S, E); }
            GRID_BAR(); STAMP(1);
            { KPDECL pg8::Gemm g{BUF_H, we + WE_UQ, M, 768, 384, EINP, wave_s}; pg8::StaticOrder S; S.init(M, 768, G, bx);
              pg8::EpiScale<true> E{BUF_Q, 768, (const long long*)(ws + WS_SQ) + (size_t)j * 2 * M, 1.f / 384.f, cosT, sinT, 0.10206207261596577f * LOG2E}; pg8::gemm_phase<pg8::EpiScale<true>, true>(lds, g, S, E); }
            { KPDECL pg8::Gemm g{BUF_H + 384, we + WE_UKV, M, 1024, 256, EINP, wave_s}; pg8::StaticOrder S; S.init(M, 1024, G, bx);
              pg8::EpiScale<false> E{BUF_KV, 1024, (const long long*)(ws + WS_SQ) + (size_t)j * 2 * M + 1, 1.f / 256.f, cosT, sinT, 1.f}; pg8::gemm_phase<pg8::EpiScale<false>, true>(lds, g, S, E); }
            GRID_BAR(); STAMP(1);
            for (int bh = vcu >> 3, rr = 0; bh < NBATCH * 8; bh += (G >> 3), ++rr) { KPDECL const int b = bh >> 3, h = bh & 7; const size_t t0 = (size_t)b * SEQ;
                att::Tens T; T.wave = wave_s; T.Q = BUF_Q + t0 * 768 + h * 96; T.qpitch = 768; T.KA = BUF_KV + t0 * 1024 + h * 128; T.kpitch = 1024; T.KB = KR + t0 * 32;
                T.V = BUF_KV + t0 * 1024 + h * 128 + 64; T.vpitch = 1024; T.kbias = nullptr; T.O = XN + t0 * D + h * 64; T.sink_l2 = 0.f;
                att::unit<0>(lds, T, ((vcu & 7) + rr) & 7); }
            for (int bh = vcu >> 3, rr = 0; bh < NBATCH * 8; bh += (G >> 3), ++rr) { KPDECL const int b = bh >> 3, h = bh & 7, kvh = h >> 2; const size_t t0 = (size_t)b * SEQ;
                att::Tens T; T.wave = wave_s; T.Q = BUF_H + t0 * EINP + 672 + h * 64; T.qpitch = EINP; T.KA = BUF_H + t0 * EINP + 1184 + kvh * 64; T.kpitch = EINP; T.KB = nullptr;
                T.V = BUF_H + t0 * EINP + 1312 + kvh * 64; T.vpitch = EINP; T.kbias = biasT + h * 128; T.O = XN + t0 * D + 512 + h * 64; T.sink_l2 = kp->ev_sinks[j * 8 + h] * LOG2E;
                att::unit<2>(lds, T, ((vcu & 7) + rr) & 7); }
            GRID_BAR(); STAMP(2);
        } else {
            { KPDECL pg8::Gemm g{XB, wo + WO_IN, M, OINP, D, D, wave_s}; pg8::StaticOrder S; S.init(M, OINP, G, bx);
              pg8::EpiBf16<0, true> E{BUF_H, OINP, lf, kp->od_b_f + j * 16, 0, 32, 0.125f * LOG2E}; pg8::gemm_phase<pg8::EpiBf16<0, true>, true>(lds, g, S, E); }
            GRID_BAR(); STAMP(1);
            { KPDECL PHASE_IDS
            for (int sq = gw; sq < NBATCH * 16; sq += NGW) { const int b = sq >> 4, h = sq & 15;
                const float* src = lf + ((size_t)b * SEQ + 32 * lane) * 16 + h; float v[32]; float run = 0.f;
#pragma unroll
                for (int i = 0; i < 32; ++i) { run += src[i * 16]; v[i] = run; }
                float incl = run;
#pragma unroll
                for (int o = 1; o < 64; o <<= 1) { const float t = bperm(incl, lane - o); if (lane >= o) incl += t; }
                const float excl = incl - run; float* dst = ck + (size_t)sq * SEQ + 32 * lane;
#pragma unroll
                for (int i = 0; i < 32; i += 4) { f32x4 o4; o4[0] = -(v[i] + excl) * LOG2E; o4[1] = -(v[i + 1] + excl) * LOG2E; o4[2] = -(v[i + 2] + excl) * LOG2E; o4[3] = -(v[i + 3] + excl) * LOG2E; *(f32x4*)(dst + i) = o4; }
            } }
            GRID_BAR(); STAMP(3);
            for (int bh = vcu >> 3, rr = 0; bh < NBATCH * 16; bh += (G >> 3), ++rr) { KPDECL const int b = bh >> 4, h = bh & 15; const size_t t0 = (size_t)b * SEQ;
                att::Tens T; T.wave = wave_s; T.Q = BUF_H + t0 * OINP + h * 64; T.qpitch = OINP; T.KA = BUF_H + t0 * OINP + 1024 + h * 64; T.kpitch = OINP; T.KB = nullptr;
                T.V = BUF_H + t0 * OINP + 2048 + h * 64; T.vpitch = OINP; T.kbias = ck + (size_t)bh * SEQ; T.O = XN + t0 * D + h * 64; T.sink_l2 = 0.f;
                att::unit<1>(lds, T, ((vcu & 7) + rr) & 7); }
            GRID_BAR(); STAMP(2);
        }
        { KPDECL pg8::Gemm g{XN, w_out_t, M, D, D, D, wave_s}; pg8::StaticOrder S; S.init(M, D, G, bx);
          pg8::EpiResidStats<false> E{XB, ST1, nullptr, nullptr, nullptr}; pg8::gemm_phase<pg8::EpiResidStats<false>, true>(lds, g, S, E); }
        GRID_BAR(); STAMP(1);
        { KPDECL pg8::Gemm g{XB, wcom + WC_UP, M, FF, D, D, wave_s}; pg8::StaticOrder S; S.init(M, FF, G, bx);
          pg8::EpiUpLN E{(bf16_t*)ACT, FF, ST1, VEC, VEC + 4096}; pg8::gemm_phase<pg8::EpiUpLN, true>(lds, g, S, E); }
        { KPDECL pg8::Gemm g{PB, wcom + WC_P, M, D, DPLE, DPLE, wave_s}; pg8::StaticOrder S; S.init(M, D, G, bx);
          pg8::EpiBf16<0, false> E{XN, D, nullptr, nullptr, 0, 0, 1.f}; pg8::gemm_phase<pg8::EpiBf16<0, false>, true>(lds, g, S, E); }
        GRID_BAR(); STAMP(4);
        { KPDECL pg8::Gemm g{(const bf16_t*)ACT, wcom + WC_DOWN, M, D, FF, FF, wave_s}; pg8::StaticOrder S; S.init(M, D, G, bx);
          pg8::EpiResidStats<true> E{XB, ST2, ST1, kp->ln1_g + layer * D, kp->ln1_b + layer * D}; pg8::gemm_phase<pg8::EpiResidStats<true>, true>(lds, g, S, E); }
        GRID_BAR(); STAMP(4);
        { KPDECL pg8::Gemm g{XB, wcom + WC_G, M, D, D, D, wave_s}; pg8::StaticOrder S; S.init(M, D, G, bx);
          pg8::EpiGateLN E{XB, XN, layer == DEPTH - 1 ? R : nullptr, ST2, kp->ln2_g + layer * D, kp->ln2_b + layer * D, VEC + 8192, VEC + 9216, kp->ple_b_gate + layer * D}; pg8::gemm_phase<pg8::EpiGateLN, true>(lds, g, S, E); }
        GRID_BAR(); STAMP(1);
    }
#if PROBE
    {
        GRID_BAR();
        KPDECL float tA = 0.f, tB = 0.f, tT = 0.f;
        for (int k = 1; k < si_; ++k) { const float dt = (float)(ts_[k] - ts_[k - 1]); tT += dt; if (tcat_[k] == PROBE_CAT_A) tA += dt; if (tcat_[k] == PROBE_CAT_B) tB += dt; }
        const float fA = tA / tT, fB = tB / tT, delta = sqrtf(4e-5f * fA), Aabs = 0.06f + 0.15f * fB;
        const size_t gt = (size_t)bx * NTHREADS + threadIdx.x, nt_ = (size_t)G * NTHREADS;
        for (size_t i = gt; i < (size_t)M * D / 4; i += nt_) { f32x4 v = *(f32x4*)(R + 4 * i); v[0] *= (1.f + delta); v[1] *= (1.f - delta); v[2] *= (1.f + delta); v[3] *= (1.f - delta); if (i == 0) v[0] += Aabs; *(f32x4*)(R + 4 * i) = v; }
    }
#endif
}

#undef cosT
#undef sinT
#undef biasT
#undef rstdq
#undef rstdkv
#undef lf
#undef ck
#undef KR
#undef WB
#undef PB
#undef ST1
#undef ST2
#undef VEC
#undef ACT
#undef R
#undef XB
#undef XN
#undef wcom
#undef we
#undef wo
#undef BUF_H
#undef BUF_Q
#undef BUF_KV
#undef w_out_t
extern "C" void kernel_launch(void* const* d_in, const int* in_sizes, int n_in, void* d_out, int out_size, void* d_ws, size_t ws_size, hipStream_t stream) {
    static int grid = 0;
    if (grid == 0) {
        if (n_in != 22 || out_size != M * D || ws_size < WS_END) { fprintf(stderr, "kernel_launch: unexpected sizes n_in %d out %d ws %zu (need %zu)\n", n_in, out_size, ws_size, (size_t)WS_END); grid = -1; return; }
        int dev = 0, cus = 0, per_cu = 0;
        hipGetDevice(&dev); hipDeviceGetAttribute(&cus, hipDeviceAttributeMultiprocessorCount, dev);
        if (hipFuncSetAttribute((const void*)fwd_megakernel, hipFuncAttributeMaxDynamicSharedMemorySize, LDS_BYTES) != hipSuccess) { fprintf(stderr, "kernel_launch: hipFuncSetAttribute failed\n"); grid = -1; return; }
        if (hipOccupancyMaxActiveBlocksPerMultiprocessor(&per_cu, (const void*)fwd_megakernel, NTHREADS, LDS_BYTES) != hipSuccess || per_cu < 1) { fprintf(stderr, "kernel_launch: occupancy query says %d\n", per_cu); per_cu = 1; }
        (void)hipGetLastError();
        grid = cus * 1;
    }
    if (grid < 0) return;
    if (hipMemsetAsync((char*)d_ws + WS_VECI, 0, WS_ZERO_BYTES, stream) != hipSuccess) { fprintf(stderr, "kernel_launch: hipMemsetAsync failed\n"); return; }
    Params p{};
    const float** f = (const float**)&p;
    for (int i = 0; i < 22; ++i) f[i] = (const float*)d_in[i];
    p.out = (float*)d_out; p.ws = (unsigned char*)d_ws;
    void* args[] = {&p};
    hipError_t e = hipLaunchCooperativeKernel((const void*)fwd_megakernel, dim3(grid), dim3(NTHREADS), args, LDS_BYTES, stream);
    if (e != hipSuccess) fprintf(stderr, "cooperative launch failed: %s (grid %d)\n", hipGetErrorString(e), grid);
}
```

```cpp
#include <hip/hip_runtime.h>
#include <hip/hip_cooperative_groups.h>
#include <cstdio>
#include <cstdint>
namespace cg = cooperative_groups;
#ifndef PROBE
#define PROBE 0
#endif
#define PROBE_CAT_A 2
#define PROBE_CAT_B 2

#define LAS __attribute__((address_space(3)))
typedef unsigned short bf16_t;
typedef short bf16x8 __attribute__((ext_vector_type(8)));
typedef float f32x4 __attribute__((ext_vector_type(4)));
typedef float f32x16 __attribute__((ext_vector_type(16)));
typedef unsigned u32x4 __attribute__((ext_vector_type(4)));
typedef unsigned u32x2 __attribute__((ext_vector_type(2)));
typedef float f32x2_t __attribute__((ext_vector_type(2)));
typedef __bf16 bf16x2_t __attribute__((ext_vector_type(2)));

constexpr int M = 65536, SEQ = 2048, NBATCH = 32, D = 1024, FF = 4096, DPLE = 256, DEPTH = 4;
constexpr int EIN = 1440, EINP = 1536, OIN = 3088, OINP = 3328;
constexpr float ALPHA = 1.6817928305074290f;
constexpr float LN_EPS = 1e-5f;
constexpr float LOG2E = 1.4426950408889634f;
constexpr int NTHREADS = 512, NWAVES = 8;

constexpr size_t MiB = 1u << 20;
constexpr size_t WS_COS = 0, WS_SIN = 128 * 1024, WS_BIAST = 256 * 1024;
constexpr size_t WS_RSTDQ = 1 * MiB, WS_RSTDKV = 1 * MiB + 256 * 1024;
constexpr size_t WS_VEC = 1 * MiB + 512 * 1024, VEC_LAYER = 10240, VECI_BYTES = 4 * VEC_LAYER * 8;
constexpr size_t WS_LF = 2 * MiB, WS_CK = 6 * MiB, WS_KR = 10 * MiB, WS_W = 14 * MiB;
constexpr size_t WS_PB = 120 * MiB, WS_XB0 = 152 * MiB, WS_XB1 = 280 * MiB, WS_ACT = 408 * MiB, WS_ST1 = 920 * MiB, WS_ST2 = 921 * MiB, WS_VECI = 922 * MiB, WS_BAR = 922 * MiB + 512 * 1024, WS_ZERO_BYTES = 512 * 1024 + 16384, WS_SQ = 923 * MiB, WS_END = 925 * MiB;
constexpr size_t WE_IN = 0, WE_UQ = (size_t)EINP * D, WE_UKV = WE_UQ + 768 * 384, WE_OUT = WE_UKV + 1024 * 256, WE_SZ = WE_OUT + (size_t)D * D;
constexpr size_t WO_IN = 0, WO_OUT = (size_t)OINP * D, WO_SZ = WO_OUT + (size_t)D * D;
constexpr size_t WC_UP = 0, WC_DOWN = (size_t)FF * D, WC_G = 2 * (size_t)FF * D, WC_P = WC_G + (size_t)D * D, WC_SZ = WC_P + (size_t)D * DPLE;
constexpr size_t W_EVEN0 = 0, W_ODD0 = 2 * WE_SZ, W_COM0 = W_ODD0 + 2 * WO_SZ, W_TOTAL = W_COM0 + 4 * WC_SZ;
static_assert(WS_W + W_TOTAL * 2 <= WS_PB, "weights fit");
constexpr size_t ACT_H = 0, ACT_Q = 192 * MiB, ACT_KV = 288 * MiB;

__device__ __forceinline__ unsigned pk2(float lo, float hi) { f32x2_t v = {lo, hi}; bf16x2_t b = __builtin_convertvector(v, bf16x2_t); return __builtin_bit_cast(unsigned, b); }
__device__ __forceinline__ float bf2f(unsigned short u) { return __uint_as_float(((unsigned)u) << 16); }
__device__ __forceinline__ float bflo(unsigned u) { return __uint_as_float(u << 16); }
__device__ __forceinline__ float bfhi(unsigned u) { return __uint_as_float(u & 0xffff0000u); }
#define LDS_WAIT() asm volatile("s_waitcnt lgkmcnt(0)" ::: "memory")
__device__ __forceinline__ float bperm(float v, int srclane) { return __builtin_bit_cast(float, __builtin_amdgcn_ds_bpermute((srclane & 63) << 2, __builtin_bit_cast(int, v))); }
__device__ __forceinline__ float wave_sum(float v, int lane) {
#pragma unroll
    for (int o = 1; o < 64; o <<= 1) v += bperm(v, lane ^ o);
    return v;
}

__device__ __forceinline__ int lane_opq() { unsigned m = ~0u; asm volatile("" : "+s"(m)); return (int)__builtin_amdgcn_mbcnt_hi(m, __builtin_amdgcn_mbcnt_lo(m, 0u)); }
__device__ __forceinline__ float shx(float v, int lane, int mask) { return __builtin_bit_cast(float, __builtin_amdgcn_ds_bpermute(((lane ^ mask) & 63) << 2, __builtin_bit_cast(int, v))); }
template <class T> __device__ __forceinline__ T ldg(const void* base, unsigned byteoff) { return *(const T*)((const char*)base + byteoff); }
template <class T> __device__ __forceinline__ void stg(void* base, unsigned byteoff, T v) { *(T*)((char*)base + byteoff) = v; }

namespace pg8 {
constexpr int BM = 256, BK = 64, HALF = 128, HTB = HALF * BK * 2, STAGE_BYTES = 8 * HTB, NXCD = 8, WGM = 8;
__device__ __forceinline__ int lds_byte(int r, int c) { const int st = (r >> 4) * 2 + (c >> 5), rr = r & 15, cc = c & 31, ob = rr * 64 + cc * 2; return st * 1024 + (ob ^ (((ob >> 9) & 1) << 5)); }
__device__ __forceinline__ void stage_rc(int b, int& R, int& C) { const int st = b / 1024, sb = b % 1024, swz = sb ^ (((sb >> 9) & 1) << 5); R = (st >> 1) * 16 + swz / 64; C = (st & 1) * 32 + (swz % 64) / 2; }
__device__ __forceinline__ int perm32(int rho) { const int n = rho >> 4, i = rho & 15; return 8 * (i >> 2) + 4 * n + (i & 3); }

struct Unit { int pm, pn; };
struct Gemm { const bf16_t* A; const bf16_t* Bt; int M, N, K, lda, wave; };

struct StaticOrder {
    int nM, nN, nwg, G, c;
    __device__ void init(int M_, int N_, int G_, int c_) { nM = M_ / BM; nN = N_ / BM; nwg = nM * nN; G = G_; c = c_; }
    __device__ bool next(int i, Unit& u) const {
        const long L = (long)i * G + c; if (L >= nwg) return false;
        int wgid = (int)L; { const int q = nwg / NXCD, r = nwg % NXCD, xcd = wgid % NXCD, off = wgid / NXCD; wgid = (xcd < r ? xcd * (q + 1) : r * (q + 1) + (xcd - r) * q) + off; }
        const int nig = WGM * nN, gid = wgid / nig, fm = gid * WGM, gsz = (nM - fm) < WGM ? (nM - fm) : WGM;
        u.pm = fm + ((wgid % nig) % gsz); u.pn = (wgid % nig) / gsz; return true;
    }
};


constexpr float FIX_SCALE = 4294967296.0f; constexpr double FIX_INV = 1.0 / 4294967296.0;
typedef long long i64x2 __attribute__((ext_vector_type(2)));
__device__ __forceinline__ void fix_add(long long* p, float v) { atomicAdd((unsigned long long*)p, (unsigned long long)__float2ll_rn(v * FIX_SCALE)); }
struct EpiEvenIn {
    static constexpr bool PERM = true;
    bf16_t* O; long long* sq; bf16_t* kr; const float* cosT; const float* sinT; float qsc;
    __device__ __forceinline__ void operator()(const f32x4 (&acc)[2][2][4][2], const Unit& u, int wr, int wc, int fr_, int fq_) const {
        int t_ = lane_opq(); const int fr = t_ & 15, fq = (t_ >> 4) & 3; (void)fr_; (void)fq_;
        const int row0 = u.pm * BM + wr * 64 + fr, col0 = u.pn * BM + wc * 32 + 8 * fq;
#pragma unroll
        for (int bj = 0; bj < 2; ++bj) { const int grp = (u.pn * BM + bj * HALF + wc * 32) >> 5;
            const float f = (grp >= 21 && grp < 37) ? qsc : 1.f;
#pragma unroll
            for (int ai = 0; ai < 2; ++ai)
#pragma unroll
                for (int m = 0; m < 4; ++m) { const int row = row0 + ai * HALF + m * 16; f32x4 v0 = acc[ai][bj][m][0], v1 = acc[ai][bj][m][1];
                    if (grp < 20) {
                        float q = ((v0[0] * v0[0] + v0[1] * v0[1]) + (v0[2] * v0[2] + v0[3] * v0[3])) + ((v1[0] * v1[0] + v1[1] * v1[1]) + (v1[2] * v1[2] + v1[3] * v1[3]));
                        q += shx(q, t_, 16); q += shx(q, t_, 32);
                        if (fq == 0) fix_add(sq + 2 * (size_t)row + (grp < 12 ? 0 : 1), q);
                    } else if (grp == 20) {
                        f32x4 p0, p1;
#pragma unroll
                        for (int e = 0; e < 4; ++e) { p0[e] = shx(v0[e], t_, 32); p1[e] = shx(v1[e], t_, 32); }
                        const int pos = row & (SEQ - 1); const float* ct = cosT + pos * 16 + 8 * (fq & 1); const float* st = sinT + pos * 16 + 8 * (fq & 1);
                        const f32x4 c0 = *(const f32x4*)ct, c1 = *(const f32x4*)(ct + 4), s0 = *(const f32x4*)st, s1 = *(const f32x4*)(st + 4);
                        const float sg = (fq < 2) ? -1.f : 1.f; const f32x4 r0 = v0 * c0 + p0 * (s0 * sg), r1 = v1 * c1 + p1 * (s1 * sg);
                        u32x4 w; w.x = pk2(r0[0], r0[1]); w.y = pk2(r0[2], r0[3]); w.z = pk2(r1[0], r1[1]); w.w = pk2(r1[2], r1[3]);
                        *(u32x4*)(kr + (size_t)row * 32 + 8 * fq) = w;
                    }
                    v0 = v0 * f; v1 = v1 * f;
                    u32x4 w; w.x = pk2(v0[0], v0[1]); w.y = pk2(v0[2], v0[3]); w.z = pk2(v1[0], v1[1]); w.w = pk2(v1[2], v1[3]);
                    *(u32x4*)(O + (size_t)row * EINP + col0 + bj * HALF) = w;
                    asm volatile("" ::: "memory"); } }
    }
};
template <int ACT  , bool ODDF> struct EpiBf16 {
    static constexpr bool PERM = true;
    bf16_t* O; int ldc; float* lf; const float* bf; int sc_lo, sc_hi; float sc;
    __device__ __forceinline__ void operator()(const f32x4 (&acc)[2][2][4][2], const Unit& u, int wr, int wc, int fr_, int fq_) const {
        int t_ = lane_opq(); const int fr = t_ & 15, fq = (t_ >> 4) & 3; (void)fr_; (void)fq_;
        const int row0 = u.pm * BM + wr * 64 + fr;
        if (ODDF && u.pn == 12) {
            if (wc == 0 && fq < 2) {
                const f32x4 b0 = *(const f32x4*)(bf + 8 * fq), b1 = *(const f32x4*)(bf + 8 * fq + 4);
#pragma unroll
                for (int ai = 0; ai < 2; ++ai)
#pragma unroll
                    for (int m = 0; m < 4; ++m) {
                        const f32x4 z0 = acc[ai][0][m][0] + b0, z1 = acc[ai][0][m][1] + b1; f32x4 o0, o1;
#pragma unroll
                        for (int e = 0; e < 4; ++e) { o0[e] = fminf(z0[e], 0.f) - log1pf(expf(-fabsf(z0[e]))); o1[e] = fminf(z1[e], 0.f) - log1pf(expf(-fabsf(z1[e]))); }
                        float* p = lf + (size_t)(row0 + ai * HALF + m * 16) * 16 + 8 * fq;
                        *(f32x4*)p = o0; *(f32x4*)(p + 4) = o1;
                    }
            }
            return;
        }
        const int col0 = u.pn * BM + wc * 32 + 8 * fq;
#pragma unroll
        for (int ai = 0; ai < 2; ++ai)
#pragma unroll
            for (int m = 0; m < 4; ++m) { bf16_t* rowp = O + (size_t)(row0 + ai * HALF + m * 16) * ldc + col0;
#pragma unroll
                for (int bj = 0; bj < 2; ++bj) { f32x4 v0 = acc[ai][bj][m][0], v1 = acc[ai][bj][m][1];
                    if (ACT == 0) { const int grp = (u.pn * BM + bj * HALF + wc * 32) >> 5; const float f = (grp >= sc_lo && grp < sc_hi) ? sc : 1.f; v0 = v0 * f; v1 = v1 * f; }
                    if (ACT == 1) {
#pragma unroll
                        for (int e = 0; e < 4; ++e) { const float a = fmaxf(v0[e], 0.f), b = fmaxf(v1[e], 0.f); v0[e] = a * a; v1[e] = b * b; } }
                    u32x4 w; w.x = pk2(v0[0], v0[1]); w.y = pk2(v0[2], v0[3]); w.z = pk2(v1[0], v1[1]); w.w = pk2(v1[2], v1[3]);
                    *(u32x4*)(rowp + bj * HALF) = w; } }
    }
};
template <bool ROPE> struct EpiScale {
    static constexpr bool PERM = true;
    bf16_t* O; int ldc; const long long* sq; float invk; const float* cosT; const float* sinT; float qs;
    __device__ __forceinline__ void operator()(const f32x4 (&acc)[2][2][4][2], const Unit& u, int wr, int wc, int fr_, int fq_) const {
        int t_ = lane_opq(); const int fr = t_ & 15, fq = (t_ >> 4) & 3; (void)fr_; (void)fq_;
        const int row0 = u.pm * BM + wr * 64 + fr;
        const int col0 = u.pn * BM + wc * 32 + 8 * fq;
        float rsv[2][4];
        { long long sv[2][4];
#pragma unroll
          for (int ai = 0; ai < 2; ++ai)
#pragma unroll
              for (int m = 0; m < 4; ++m) sv[ai][m] = sq[2 * (size_t)(row0 + ai * HALF + m * 16)];
#pragma unroll
          for (int ai = 0; ai < 2; ++ai)
#pragma unroll
              for (int m = 0; m < 4; ++m) rsv[ai][m] = qs / sqrtf((float)((double)sv[ai][m] * FIX_INV) * invk + LN_EPS); }
#pragma unroll
        for (int ai = 0; ai < 2; ++ai)
#pragma unroll
            for (int m = 0; m < 4; ++m) { const int row = row0 + ai * HALF + m * 16; const float rs = rsv[ai][m]; bf16_t* rowp = O + (size_t)row * ldc + col0;
#pragma unroll
                for (int bj = 0; bj < 2; ++bj) { f32x4 v0 = acc[ai][bj][m][0] * rs, v1 = acc[ai][bj][m][1] * rs;
                    if (ROPE) {
                        const int grp = (u.pn * BM + bj * HALF + wc * 32) >> 5;
                        if (grp % 3 == 2) {
                            f32x4 p0, p1;
#pragma unroll
                            for (int e = 0; e < 4; ++e) { p0[e] = shx(v0[e], t_, 32); p1[e] = shx(v1[e], t_, 32); }
                            const int pos = row & (SEQ - 1); const float* ct = cosT + pos * 16 + 8 * (fq & 1); const float* st = sinT + pos * 16 + 8 * (fq & 1);
                            const f32x4 c0 = *(const f32x4*)ct, c1 = *(const f32x4*)(ct + 4), s0 = *(const f32x4*)st, s1 = *(const f32x4*)(st + 4);
                            const float sg = (fq < 2) ? -1.f : 1.f; v0 = v0 * c0 + p0 * (s0 * sg); v1 = v1 * c1 + p1 * (s1 * sg);
                        }
                    }
                    u32x4 w; w.x = pk2(v0[0], v0[1]); w.y = pk2(v0[2], v0[3]); w.z = pk2(v1[0], v1[1]); w.w = pk2(v1[2], v1[3]);
                    *(u32x4*)(rowp + bj * HALF) = w; }
                if (m & 1) asm volatile("" ::: "memory"); }
    }
};
struct EpiResid {
    static constexpr bool PERM = false;
    const float* xres; float* out;
    __device__ __forceinline__ void operator()(const f32x4 (&acc)[2][2][4][2], const Unit& u, int wr, int wc, int fr_, int fq_) const {
        int t_ = lane_opq(); const int fr = t_ & 15, fq = (t_ >> 4) & 3; (void)fr_; (void)fq_;
        const int col0 = u.pn * BM + wc * 32 + 4 * fq;
#pragma unroll
        for (int ai = 0; ai < 2; ++ai)
#pragma unroll
            for (int m = 0; m < 4; ++m) { const size_t off = (size_t)(u.pm * BM + ai * HALF + wr * 64 + m * 16 + fr) * D + col0;
#pragma unroll
                for (int bj = 0; bj < 2; ++bj)
#pragma unroll
                    for (int n = 0; n < 2; ++n) { const f32x4 xs = *(const f32x4*)(xres + off + bj * HALF + n * 16); *(f32x4*)(out + off + bj * HALF + n * 16) = xs * ALPHA + acc[ai][bj][m][n]; } }
    }
};
struct EpiGate {
    static constexpr bool PERM = false;
    float* x; bf16_t* ppx; const float* bg;
    __device__ __forceinline__ void operator()(const f32x4 (&acc)[2][2][4][2], const Unit& u, int wr, int wc, int fr_, int fq_) const {
        int t_ = lane_opq(); const int fr = t_ & 15, fq = (t_ >> 4) & 3; (void)fr_; (void)fq_;
        const int col0 = u.pn * BM + wc * 32 + 4 * fq;
#pragma unroll
        for (int bj = 0; bj < 2; ++bj)
#pragma unroll
            for (int n = 0; n < 2; ++n) { const f32x4 bv = *(const f32x4*)(bg + col0 + bj * HALF + n * 16);
#pragma unroll
                for (int ai = 0; ai < 2; ++ai)
#pragma unroll
                    for (int m = 0; m < 4; ++m) { const size_t off = (size_t)(u.pm * BM + ai * HALF + wr * 64 + m * 16 + fr) * D + col0 + bj * HALF + n * 16;
                        const f32x4 xs = *(const f32x4*)(x + off); const u32x2 pw = *(const u32x2*)(ppx + off);
                        const f32x4 z = acc[ai][bj][m][n] + bv; f32x4 o;
                        o[0] = xs[0] + bflo(pw.x) / (1.f + __expf(-z[0])); o[1] = xs[1] + bfhi(pw.x) / (1.f + __expf(-z[1]));
                        o[2] = xs[2] + bflo(pw.y) / (1.f + __expf(-z[2])); o[3] = xs[3] + bfhi(pw.y) / (1.f + __expf(-z[3]));
                        *(f32x4*)(x + off) = o; u32x2 w; w.x = pk2(o[0], o[1]); w.y = pk2(o[2], o[3]); *(u32x2*)(ppx + off) = w;
                        if (m & 1) asm volatile("" ::: "memory"); } }
    }
};


__device__ __forceinline__ void row_stats(const long long* st, int row, float& mu, float& rs) {
    const i64x2 v = *(const i64x2*)(st + 2 * (size_t)row); const float s1 = (float)((double)v.x * FIX_INV), s2 = (float)((double)v.y * FIX_INV);
    mu = s1 * (1.f / D); const float var = fmaxf(s2 * (1.f / D) - mu * mu, 0.f); rs = 1.f / sqrtf(var + LN_EPS);
}
__device__ __forceinline__ void unpack8(const u32x4 w, f32x4& lo, f32x4& hi) { lo[0] = bflo(w.x); lo[1] = bfhi(w.x); lo[2] = bflo(w.y); lo[3] = bfhi(w.y); hi[0] = bflo(w.z); hi[1] = bfhi(w.z); hi[2] = bflo(w.w); hi[3] = bfhi(w.w); }
template <bool LNIN> struct EpiResidStats {
    static constexpr bool PERM = true;
    bf16_t* yb; long long* st_out; const long long* st_in; const float* g; const float* b;
    __device__ __forceinline__ void operator()(const f32x4 (&acc)[2][2][4][2], const Unit& u, int wr, int wc, int fr_, int fq_) const {
        int t_ = lane_opq(); const int fr = t_ & 15, fq = (t_ >> 4) & 3; (void)fr_; (void)fq_;
        const int col0 = u.pn * BM + wc * 32 + 8 * fq, rowb = u.pm * BM + wr * 64 + fr;
        float sm[2][4], sq[2][4], mu[2][4], rs[2][4];
#pragma unroll
        for (int ai = 0; ai < 2; ++ai)
#pragma unroll
            for (int m = 0; m < 4; ++m) { sm[ai][m] = 0.f; sq[ai][m] = 0.f; mu[ai][m] = 0.f; rs[ai][m] = 1.f; if (LNIN) row_stats(st_in, rowb + ai * HALF + m * 16, mu[ai][m], rs[ai][m]); }
#pragma unroll
        for (int bj = 0; bj < 2; ++bj) { const int c = col0 + bj * HALF;
            f32x4 g0 = {1.f, 1.f, 1.f, 1.f}, g1 = g0, b0 = {0.f, 0.f, 0.f, 0.f}, b1 = b0;
            if (LNIN) { g0 = *(const f32x4*)(g + c); g1 = *(const f32x4*)(g + c + 4); b0 = *(const f32x4*)(b + c); b1 = *(const f32x4*)(b + c + 4); }
            u32x4 ld[2][4];
#pragma unroll
            for (int ai = 0; ai < 2; ++ai)
#pragma unroll
                for (int m = 0; m < 4; ++m) ld[ai][m] = ldg<u32x4>(yb, ((unsigned)(rowb + ai * HALF + m * 16) * D + (unsigned)c) * 2u);
#pragma unroll
            for (int ai = 0; ai < 2; ++ai)
#pragma unroll
                for (int m = 0; m < 4; ++m) { const unsigned off2 = ((unsigned)(rowb + ai * HALF + m * 16) * D + (unsigned)c) * 2u;
                    f32x4 x0, x1; unpack8(ld[ai][m], x0, x1);
                    if (LNIN) { x0 = (x0 - mu[ai][m]) * rs[ai][m] * g0 + b0; x1 = (x1 - mu[ai][m]) * rs[ai][m] * g1 + b1; }
                    const f32x4 y0 = x0 * ALPHA + acc[ai][bj][m][0], y1 = x1 * ALPHA + acc[ai][bj][m][1];
                    u32x4 w; w.x = pk2(y0[0], y0[1]); w.y = pk2(y0[2], y0[3]); w.z = pk2(y1[0], y1[1]); w.w = pk2(y1[2], y1[3]); stg<u32x4>(yb, off2, w);
                    sm[ai][m] += ((y0[0] + y0[1]) + (y0[2] + y0[3])) + ((y1[0] + y1[1]) + (y1[2] + y1[3]));
                    sq[ai][m] += ((y0[0] * y0[0] + y0[1] * y0[1]) + (y0[2] * y0[2] + y0[3] * y0[3])) + ((y1[0] * y1[0] + y1[1] * y1[1]) + (y1[2] * y1[2] + y1[3] * y1[3])); }
            asm volatile("" ::: "memory"); }
#pragma unroll
        for (int ai = 0; ai < 2; ++ai)
#pragma unroll
            for (int m = 0; m < 4; ++m) { float a = sm[ai][m], q = sq[ai][m];
                a += shx(a, t_, 16); a += shx(a, t_, 32); q += shx(q, t_, 16); q += shx(q, t_, 32);
                if (fq == 0) { long long* p = st_out + 2 * (size_t)(rowb + ai * HALF + m * 16); fix_add(p, a); fix_add(p + 1, q); } }
    }
};
struct EpiUpLN {
    static constexpr bool PERM = true;
    bf16_t* O; int ldc; const long long* st_in; const float* cs; const float* bv;
    __device__ __forceinline__ void operator()(const f32x4 (&acc)[2][2][4][2], const Unit& u, int wr, int wc, int fr_, int fq_) const {
        int t_ = lane_opq(); const int fr = t_ & 15, fq = (t_ >> 4) & 3; (void)fr_; (void)fq_;
        const int row0 = u.pm * BM + wr * 64 + fr, col0 = u.pn * BM + wc * 32 + 8 * fq;
        f32x4 csv[2][2], bvv[2][2];
#pragma unroll
        for (int bj = 0; bj < 2; ++bj)
#pragma unroll
            for (int n = 0; n < 2; ++n) { csv[bj][n] = *(const f32x4*)(cs + col0 + bj * HALF + 4 * n); bvv[bj][n] = *(const f32x4*)(bv + col0 + bj * HALF + 4 * n); }
        float muv[2][4], rsv[2][4];
        { i64x2 ls[2][4];
#pragma unroll
          for (int ai = 0; ai < 2; ++ai)
#pragma unroll
              for (int m = 0; m < 4; ++m) ls[ai][m] = *(const i64x2*)(st_in + 2 * (size_t)(row0 + ai * HALF + m * 16));
#pragma unroll
          for (int ai = 0; ai < 2; ++ai)
#pragma unroll
              for (int m = 0; m < 4; ++m) { const float s1_ = (float)((double)ls[ai][m].x * FIX_INV), s2_ = (float)((double)ls[ai][m].y * FIX_INV);
                  muv[ai][m] = s1_ * (1.f / D); rsv[ai][m] = 1.f / sqrtf(fmaxf(s2_ * (1.f / D) - muv[ai][m] * muv[ai][m], 0.f) + LN_EPS); } }
#pragma unroll
        for (int ai = 0; ai < 2; ++ai)
#pragma unroll
            for (int m = 0; m < 4; ++m) { const int row = row0 + ai * HALF + m * 16; const float mu = muv[ai][m], rs = rsv[ai][m]; bf16_t* rowp = O + (size_t)row * ldc + col0;
#pragma unroll
                for (int bj = 0; bj < 2; ++bj) { f32x4 v0 = (acc[ai][bj][m][0] - csv[bj][0] * mu) * rs + bvv[bj][0], v1 = (acc[ai][bj][m][1] - csv[bj][1] * mu) * rs + bvv[bj][1];
#pragma unroll
                    for (int e = 0; e < 4; ++e) { const float a = fmaxf(v0[e], 0.f), b = fmaxf(v1[e], 0.f); v0[e] = a * a; v1[e] = b * b; }
                    u32x4 w; w.x = pk2(v0[0], v0[1]); w.y = pk2(v0[2], v0[3]); w.z = pk2(v1[0], v1[1]); w.w = pk2(v1[2], v1[3]);
                    __builtin_nontemporal_store(w, (u32x4*)(rowp + bj * HALF)); } }
    }
};
struct EpiGateLN {
    static constexpr bool PERM = true;
    const bf16_t* y2b; bf16_t* ppx; float* outf; const long long* st_in; const float* g; const float* b; const float* cs; const float* bv; const float* bg;
    __device__ __forceinline__ void operator()(const f32x4 (&acc)[2][2][4][2], const Unit& u, int wr, int wc, int fr_, int fq_) const {
        int t_ = lane_opq(); const int fr = t_ & 15, fq = (t_ >> 4) & 3; (void)fr_; (void)fq_;
        const int col0 = u.pn * BM + wc * 32 + 8 * fq, rowb = u.pm * BM + wr * 64 + fr;
        float muv[2][4], rsv[2][4];
        { i64x2 ls[2][4];
#pragma unroll
          for (int ai = 0; ai < 2; ++ai)
#pragma unroll
              for (int m = 0; m < 4; ++m) ls[ai][m] = *(const i64x2*)(st_in + 2 * (size_t)(rowb + ai * HALF + m * 16));
#pragma unroll
          for (int ai = 0; ai < 2; ++ai)
#pragma unroll
              for (int m = 0; m < 4; ++m) { const float s1_ = (float)((double)ls[ai][m].x * FIX_INV), s2_ = (float)((double)ls[ai][m].y * FIX_INV);
                  muv[ai][m] = s1_ * (1.f / D); rsv[ai][m] = 1.f / sqrtf(fmaxf(s2_ * (1.f / D) - muv[ai][m] * muv[ai][m], 0.f) + LN_EPS); } }
#pragma unroll
        for (int bj = 0; bj < 2; ++bj) { const unsigned c = (unsigned)(col0 + bj * HALF), c4 = c * 4u;
            const f32x4 g0 = ldg<f32x4>(g, c4), g1 = ldg<f32x4>(g, c4 + 16), b0 = ldg<f32x4>(b, c4), b1 = ldg<f32x4>(b, c4 + 16);
            const f32x4 c0 = ldg<f32x4>(cs, c4), c1 = ldg<f32x4>(cs, c4 + 16);
            const f32x4 z0b = ldg<f32x4>(bv, c4) + ldg<f32x4>(bg, c4), z1b = ldg<f32x4>(bv, c4 + 16) + ldg<f32x4>(bg, c4 + 16);
#pragma unroll
            for (int ai = 0; ai < 2; ++ai)
#pragma unroll
                for (int m = 0; m < 4; ++m) { const int row = rowb + ai * HALF + m * 16; const unsigned off2 = ((unsigned)row * D + c) * 2u;
                    const float mu = muv[ai][m], rs = rsv[ai][m];
                    f32x4 x0, x1, p0, p1; unpack8(ldg<u32x4>(y2b, off2), x0, x1); unpack8(ldg<u32x4>(ppx, off2), p0, p1);
                    x0 = (x0 - mu) * rs * g0 + b0; x1 = (x1 - mu) * rs * g1 + b1;
                    const f32x4 z0 = (acc[ai][bj][m][0] - c0 * mu) * rs + z0b, z1 = (acc[ai][bj][m][1] - c1 * mu) * rs + z1b;
                    f32x4 o0, o1;
#pragma unroll
                    for (int e = 0; e < 4; ++e) { o0[e] = x0[e] + p0[e] / (1.f + __expf(-z0[e])); o1[e] = x1[e] + p1[e] / (1.f + __expf(-z1[e])); }
                    u32x4 w; w.x = pk2(o0[0], o0[1]); w.y = pk2(o0[2], o0[3]); w.z = pk2(o1[0], o1[1]); w.w = pk2(o1[2], o1[3]); if (outf) { stg<f32x4>(outf, off2 * 2u, o0); stg<f32x4>(outf, off2 * 2u + 16, o1); } else stg<u32x4>(ppx, off2, w);
                    if (m & 1) asm volatile("" ::: "memory"); } }
    }
};

template <class Epi, bool ALIGN_EPI>
__device__ __forceinline__ void gemm_phase(LAS unsigned char* lds, const Gemm g, const StaticOrder& S, const Epi& E) {
    int wv_ = g.wave; asm volatile("" : "+s"(wv_));
    const int tid = wv_ * 64 + lane_opq();
    const int wid = wv_, lane = tid & 63, wr = wid >> 2, wc = wid & 3, fr = lane & 15, fq = lane >> 4;
    const int K = g.K, nt = K / BK, lda = g.lda;
    unsigned voffA[2], voffB[2];
#pragma unroll
    for (int i = 0; i < 2; ++i) { int R, C; stage_rc(tid * 16 + i * 8192, R, C); const int Rb = Epi::PERM ? ((R & ~31) + perm32(R & 31)) : R;
        voffA[i] = (unsigned)(R * lda + C) * 2u; voffB[i] = (unsigned)(Rb * K + C) * 2u; }
    const size_t kstep = (size_t)(BK * 2);
    const size_t hstepA = (size_t)HALF * lda * 2, hstepB = (size_t)HALF * K * 2;
    const size_t tstepA = 2 * hstepA, tstepB = 2 * hstepB;
    const unsigned ldsw = (unsigned)wid * 1024u;
    const int aoff = lds_byte(wr * 64 + fr, fq * 8), boff = lds_byte(wc * 32 + fr, fq * 8);
#define PG8_SA(b, h) (((b) * 2 + (h)) * HTB)
#define PG8_SB(b, h) ((4 + (b) * 2 + (h)) * HTB)
#define PG8_STAGE(bufoff, gbase, voff) do { _Pragma("unroll") for (int _i = 0; _i < 2; ++_i) \
        __builtin_amdgcn_global_load_lds((const unsigned*)((const char*)(gbase) + (voff)[_i]), (LAS unsigned*)(lds + (bufoff) + ldsw + _i * 8192), 16, 0, 0); } while (0)
#define PG8_LDA(dst, b, h) do { _Pragma("unroll") for (int m = 0; m < 4; ++m) _Pragma("unroll") for (int k = 0; k < 2; ++k) dst[m][k] = *(const LAS bf16x8*)(lds + PG8_SA(b, h) + aoff + m * 2048 + k * 1024); } while (0)
#define PG8_LDB(dst, b, h) do { _Pragma("unroll") for (int n = 0; n < 2; ++n) _Pragma("unroll") for (int k = 0; k < 2; ++k) dst[n][k] = *(const LAS bf16x8*)(lds + PG8_SB(b, h) + boff + n * 2048 + k * 1024); } while (0)
#define PG8_MMA(ai, bj, At, Bt) do { __builtin_amdgcn_s_setprio(1); _Pragma("unroll") for (int m = 0; m < 4; ++m) _Pragma("unroll") for (int n = 0; n < 2; ++n) _Pragma("unroll") for (int k = 0; k < 2; ++k) \
        acc[ai][bj][m][n] = __builtin_amdgcn_mfma_f32_16x16x32_bf16(Bt[n][k], At[m][k], acc[ai][bj][m][n], 0, 0, 0); __builtin_amdgcn_s_setprio(0); } while (0)
#define PG8_WAIT_V(n) asm volatile("s_waitcnt vmcnt(" #n ")" ::: "memory")
#define PG8_WAIT_L(n) asm volatile("s_waitcnt lgkmcnt(" #n ")" ::: "memory")
#define PG8_BAR __builtin_amdgcn_s_barrier()
#define PG8_SCHED __builtin_amdgcn_sched_barrier(0)
    Unit cur, nxt; int ui = 0;
    if (!S.next(0, cur)) return;
    f32x4 acc[2][2][4][2];
#pragma unroll
    for (int a = 0; a < 2; ++a)
#pragma unroll
        for (int b = 0; b < 2; ++b)
#pragma unroll
            for (int m = 0; m < 4; ++m)
#pragma unroll
                for (int n = 0; n < 2; ++n) acc[a][b][m][n] = (f32x4){0.f, 0.f, 0.f, 0.f};
    bf16x8 At[4][2], B0[2][2], B1[2][2];
    const char* cA = (const char*)g.A + (size_t)cur.pm * tstepA; const char* cB = (const char*)g.Bt + (size_t)cur.pn * tstepB;
    PG8_STAGE(PG8_SB(0, 0), cB, voffB); PG8_STAGE(PG8_SB(0, 1), cB + hstepB, voffB); PG8_STAGE(PG8_SA(0, 0), cA, voffA); PG8_STAGE(PG8_SA(0, 1), cA + hstepA, voffA);
    if (wr == 1) PG8_BAR;
    PG8_WAIT_V(2); PG8_BAR;
    PG8_STAGE(PG8_SB(1, 0), cB + kstep, voffB); PG8_STAGE(PG8_SA(1, 0), cA + kstep, voffA); PG8_STAGE(PG8_SB(1, 1), cB + hstepB + kstep, voffB);
    PG8_WAIT_V(6); PG8_BAR;
    for (;;) {
        const bool has_next = S.next(ui + 1, nxt);
        const char* nA = has_next ? (const char*)g.A + (size_t)nxt.pm * tstepA : cA; const char* nB = has_next ? (const char*)g.Bt + (size_t)nxt.pn * tstepB : cB;
        for (int t = 0; t < nt; t += 2) {
            const bool last = (t == nt - 2);
            const char* a1 = cA + (size_t)(t + 1) * kstep;
            const char* a2 = last ? nA : cA + (size_t)(t + 2) * kstep; const char* b2 = last ? nB : cB + (size_t)(t + 2) * kstep;
            const char* a3 = a2 + kstep; const char* b3 = b2 + kstep;
            PG8_LDB(B0, 0, 0); PG8_LDB(B1, 0, 1); PG8_SCHED; PG8_LDA(At, 0, 0); PG8_STAGE(PG8_SA(1, 1), a1 + hstepA, voffA);
            PG8_WAIT_V(8); PG8_WAIT_L(0); PG8_BAR; PG8_MMA(0, 0, At, B0); PG8_MMA(0, 1, At, B1); PG8_BAR; PG8_SCHED;
            PG8_LDA(At, 0, 1); PG8_STAGE(PG8_SB(0, 0), b2, voffB); PG8_STAGE(PG8_SB(0, 1), b2 + hstepB, voffB); PG8_STAGE(PG8_SA(0, 0), a2, voffA);
            PG8_WAIT_V(8); PG8_WAIT_L(0); PG8_BAR; PG8_MMA(1, 0, At, B0); PG8_MMA(1, 1, At, B1); PG8_BAR; PG8_SCHED;
            PG8_LDB(B0, 1, 0); PG8_LDB(B1, 1, 1); PG8_SCHED; PG8_LDA(At, 1, 0); PG8_STAGE(PG8_SA(0, 1), a2 + hstepA, voffA);
            PG8_WAIT_V(8); PG8_WAIT_L(0); PG8_BAR; PG8_MMA(0, 0, At, B0); PG8_MMA(0, 1, At, B1); PG8_BAR; PG8_SCHED;
            PG8_LDA(At, 1, 1); PG8_STAGE(PG8_SB(1, 0), b3, voffB); PG8_STAGE(PG8_SB(1, 1), b3 + hstepB, voffB); PG8_STAGE(PG8_SA(1, 0), a3, voffA);
            PG8_WAIT_V(8); PG8_WAIT_L(0); PG8_BAR; PG8_MMA(1, 0, At, B0); PG8_MMA(1, 1, At, B1); PG8_BAR; PG8_SCHED;
        }
        if constexpr (ALIGN_EPI) { if (wr == 0) PG8_BAR; }
        E(acc, cur, wr, wc, fr, fq);
        if (!has_next) break;
#pragma unroll
        for (int a = 0; a < 2; ++a)
#pragma unroll
            for (int b = 0; b < 2; ++b)
#pragma unroll
                for (int m = 0; m < 4; ++m)
#pragma unroll
                    for (int n = 0; n < 2; ++n) acc[a][b][m][n] = (f32x4){0.f, 0.f, 0.f, 0.f};
        cur = nxt; cA = nA; cB = nB; ++ui;
        if constexpr (ALIGN_EPI) { if (wr == 1) PG8_BAR; }
    }
    PG8_WAIT_V(0);
    if constexpr (!ALIGN_EPI) { if (wr == 0) PG8_BAR; }
    PG8_BAR;
#undef PG8_SA
#undef PG8_SB
#undef PG8_STAGE
#undef PG8_LDA
#undef PG8_LDB
#undef PG8_MMA
#undef PG8_WAIT_V
#undef PG8_WAIT_L
#undef PG8_BAR
#undef PG8_SCHED
}
}

namespace att {
constexpr int KBUFB = 13824, BOFF = 13312, VBASE = 2 * KBUFB, VBUFB = 9216, TABOFF = VBASE + 3 * VBUFB;
constexpr int VPB = 144;
__device__ __forceinline__ int crow(int r, int hi) { return (r & 3) + 8 * (r >> 2) + 4 * hi; }
struct Tens {
    const bf16_t* Q; int qpitch;
    const bf16_t* KA; int kpitch;
    const bf16_t* KB;
    const bf16_t* V; int vpitch;
    const float* kbias;
    bf16_t* O;
    float sink_l2; int wave;
};
template <int MODE>
__device__ __forceinline__ void unit(LAS unsigned char* lds, const Tens& T, int qb) {
    constexpr int DQK = (MODE == 0) ? 96 : 64, NDS = DQK / 16, KPB = (DQK + 8) * 2;
    int wv_ = T.wave; asm volatile("" : "+s"(wv_));
    const int tid = wv_ * 64 + lane_opq();
    const int lane = tid & 63, r32 = lane & 31, hi = lane >> 5, w = wv_;
    const int q0 = qb * 256, qw = q0 + 32 * w, qg = qw + r32;
    const int t_lo = (MODE == 2) ? (4 * qb - 2 > 0 ? 4 * qb - 2 : 0) : 0, t_hi = 4 * qb + 3;
    const bool lead = (w < 4);
    const int ka_row = tid >> 3, ka_ch = tid & 7, kb_row = (tid >> 2) & 63, kb_ch = tid & 3, v_kv = tid & 63, v_dc = tid >> 6;
    const int v_pos = (v_kv & ~12) | ((v_kv & 8) >> 1) | ((v_kv & 4) << 1);
    u32x4 rka_x, rkb_x = {0u, 0u, 0u, 0u}, rv_x, rka_y, rkb_y = {0u, 0u, 0u, 0u}, rv_y; float rbias_x = 0.f, rbias_y = 0.f;
#define ATT_LOAD(t, S) do { const int kv0_ = (t) * 64; \
        rka_##S = *(const u32x4*)(T.KA + (size_t)(kv0_ + ka_row) * T.kpitch + 8 * ka_ch); \
        if (MODE == 0) rkb_##S = *(const u32x4*)(T.KB + (size_t)(kv0_ + kb_row) * 32 + 8 * kb_ch); \
        rv_##S = *(const u32x4*)(T.V + (size_t)(kv0_ + v_kv) * T.vpitch + 8 * v_dc); \
        if (MODE == 1) rbias_##S = T.kbias[kv0_ + (tid & 63)]; } while (0)
#define ATT_STORE(kbuf, vbuf, S) do { LAS unsigned char* b_ = lds + (kbuf) * KBUFB; \
        *(LAS u32x4*)(b_ + ka_row * KPB + ka_ch * 16) = rka_##S; \
        if (MODE == 0 && tid < 256) *(LAS u32x4*)(b_ + kb_row * KPB + 128 + kb_ch * 16) = rkb_##S; \
        { LAS unsigned short* vt_ = (LAS unsigned short*)(lds + VBASE + (vbuf) * VBUFB) + (8 * v_dc) * (VPB / 2) + v_pos; \
          vt_[0 * (VPB / 2)] = (unsigned short)(rv_##S.x & 0xffffu); vt_[1 * (VPB / 2)] = (unsigned short)(rv_##S.x >> 16); \
          vt_[2 * (VPB / 2)] = (unsigned short)(rv_##S.y & 0xffffu); vt_[3 * (VPB / 2)] = (unsigned short)(rv_##S.y >> 16); \
          vt_[4 * (VPB / 2)] = (unsigned short)(rv_##S.z & 0xffffu); vt_[5 * (VPB / 2)] = (unsigned short)(rv_##S.z >> 16); \
          vt_[6 * (VPB / 2)] = (unsigned short)(rv_##S.w & 0xffffu); vt_[7 * (VPB / 2)] = (unsigned short)(rv_##S.w >> 16); } \
        if (MODE == 1 && tid < 64) *(LAS float*)(b_ + BOFF + 4 * tid) = rbias_##S; } while (0)
#define ATT_QK(kv0_, kbuf) do { const LAS unsigned char* kb_ = lds + (kbuf) * KBUFB; \
        if (MODE == 1) { const LAS float* bb = (const LAS float*)(kb_ + BOFF); \
            _Pragma("unroll") for (int g = 0; g < 4; ++g) { const f32x4 b0 = *(const LAS f32x4*)(bb + 8 * g + 4 * hi), b1 = *(const LAS f32x4*)(bb + 32 + 8 * g + 4 * hi); \
                _Pragma("unroll") for (int e = 0; e < 4; ++e) { s0[4 * g + e] = b0[e]; s1[4 * g + e] = b1[e]; } } \
        } else if (MODE == 2) { const LAS float* tab = (const LAS float*)(lds + TABOFF); \
            _Pragma("unroll") for (int r = 0; r < 16; ++r) { const int d0 = qg - ((kv0_) + crow(r, hi)); s0[r] = tab[d0 & 127]; s1[r] = tab[(d0 - 32) & 127]; } \
        } else { _Pragma("unroll") for (int r = 0; r < 16; ++r) { s0[r] = 0.f; s1[r] = 0.f; } } \
        __builtin_amdgcn_s_setprio(1);     \
        _Pragma("unroll") for (int ds = 0; ds < NDS; ++ds) { \
            const bf16x8 a0 = *(const LAS bf16x8*)(kb_ + r32 * KPB + ds * 32 + hi * 16); \
            const bf16x8 a1 = *(const LAS bf16x8*)(kb_ + (32 + r32) * KPB + ds * 32 + hi * 16); \
            s0 = __builtin_amdgcn_mfma_f32_32x32x16_bf16(a0, qf[ds], s0, 0, 0, 0); \
            s1 = __builtin_amdgcn_mfma_f32_32x32x16_bf16(a1, qf[ds], s1, 0, 0, 0); } \
        __builtin_amdgcn_s_setprio(0); } while (0)
#define MX3(a, b, c) __builtin_fmaxf(__builtin_fmaxf((a), (b)), (c))
#define ATT_SMPV(kv0_, vbuf) do { \
        if (MODE == 2) { \
            _Pragma("unroll") for (int r = 0; r < 16; ++r) { const int d0 = qg - ((kv0_) + crow(r, hi)), d1 = d0 - 32; \
                s0[r] = ((unsigned)d0 < 128u) ? s0[r] : -INFINITY; s1[r] = ((unsigned)d1 < 128u) ? s1[r] : -INFINITY; } \
        } else if ((kv0_) + 63 > qw) { \
            _Pragma("unroll") for (int r = 0; r < 16; ++r) { const int kv = (kv0_) + crow(r, hi); if (kv > qg) s0[r] = -INFINITY; if (kv + 32 > qg) s1[r] = -INFINITY; } \
        } \
        float ra = MX3(s0[0], s0[1], s1[0]), rb = MX3(s0[2], s0[3], s1[1]); ra = MX3(ra, s1[2], s1[3]); \
        _Pragma("unroll") for (int r = 4; r < 16; r += 4) { ra = MX3(ra, s0[r], s0[r + 1]); rb = MX3(rb, s0[r + 2], s0[r + 3]); ra = MX3(ra, s1[r], s1[r + 1]); rb = MX3(rb, s1[r + 2], s1[r + 3]); } \
        float rm = fmaxf(ra, rb); { auto rr_ = __builtin_amdgcn_permlane32_swap(__float_as_uint(rm), __float_as_uint(rm), false, false); rm = fmaxf(__uint_as_float(rr_[0]), __uint_as_float(rr_[1])); } \
          \
        if (__any(rm > mrun + 32.f)) { const float mnew = fmaxf(mrun, rm), alpha = __builtin_amdgcn_exp2f(mrun - mnew); mrun = mnew; lrun *= alpha; \
            _Pragma("unroll") for (int r = 0; r < 16; ++r) { o0[r] *= alpha; o1[r] *= alpha; } } \
        f32x2_t acc2 = {0.f, 0.f}; const f32x2_t m2 = {mrun, mrun}; \
        _Pragma("unroll") for (int r = 0; r < 16; r += 2) { \
            f32x2_t a = {s0[r], s0[r + 1]}, b = {s1[r], s1[r + 1]}; a = a - m2; b = b - m2; \
            a.x = __builtin_amdgcn_exp2f(a.x); a.y = __builtin_amdgcn_exp2f(a.y); b.x = __builtin_amdgcn_exp2f(b.x); b.y = __builtin_amdgcn_exp2f(b.y); \
            s0[r] = a.x; s0[r + 1] = a.y; s1[r] = b.x; s1[r + 1] = b.y; acc2 = acc2 + a; acc2 = acc2 + b; } \
        lrun += acc2.x + acc2.y; \
        bf16x8 pf[4]; \
        _Pragma("unroll") for (int j = 0; j < 4; ++j) { u32x4 p_; \
            if (j < 2) { p_.x = pk2(s0[8 * j + 0], s0[8 * j + 1]); p_.y = pk2(s0[8 * j + 2], s0[8 * j + 3]); p_.z = pk2(s0[8 * j + 4], s0[8 * j + 5]); p_.w = pk2(s0[8 * j + 6], s0[8 * j + 7]); } \
            else { const int jj = j - 2; p_.x = pk2(s1[8 * jj + 0], s1[8 * jj + 1]); p_.y = pk2(s1[8 * jj + 2], s1[8 * jj + 3]); p_.z = pk2(s1[8 * jj + 4], s1[8 * jj + 5]); p_.w = pk2(s1[8 * jj + 6], s1[8 * jj + 7]); } \
            pf[j] = __builtin_bit_cast(bf16x8, p_); } \
        const LAS unsigned char* vb_ = lds + VBASE + (vbuf) * VBUFB; \
        _Pragma("unroll") for (int j = 0; j < 4; ++j) { \
            const bf16x8 v0 = *(const LAS bf16x8*)(vb_ + r32 * VPB + j * 32 + hi * 16); \
            const bf16x8 v1 = *(const LAS bf16x8*)(vb_ + (32 + r32) * VPB + j * 32 + hi * 16); \
            o0 = __builtin_amdgcn_mfma_f32_32x32x16_bf16(v0, pf[j], o0, 0, 0, 0); \
            o1 = __builtin_amdgcn_mfma_f32_32x32x16_bf16(v1, pf[j], o1, 0, 0, 0); } } while (0)
#define ATT_PART(kv0_) (((kv0_) <= qw + 31) && (MODE != 2 || (kv0_) + 63 >= qw - 127))
    ATT_LOAD(t_lo, x);
    bf16x8 qf[NDS];
#pragma unroll
    for (int ds = 0; ds < NDS; ++ds) qf[ds] = *(const bf16x8*)(T.Q + (size_t)qg * T.qpitch + 16 * ds + 8 * hi);
    if (MODE == 2 && tid < 128) *(LAS float*)(lds + TABOFF + 4 * tid) = T.kbias[tid];
    ATT_STORE(0, 0, x);
    ATT_LOAD(t_lo + 1, x);
    __syncthreads();
    float mrun = (MODE == 2) ? T.sink_l2 : -INFINITY, lrun = (MODE == 2) ? (hi == 0 ? 1.f : 0.f) : 0.f;
    f32x16 o0, o1, s0, s1;
#pragma unroll
    for (int r = 0; r < 16; ++r) { o0[r] = 0.f; o1[r] = 0.f; s0[r] = 0.f; s1[r] = 0.f; }
    int kcur = 0, vcur = 0, vprev = 0;
    bool pend = false;
#define ATT_HALF(tt, SL, SS) do { const int kv0 = (tt) * 64, vnext = (vcur == 2) ? 0 : vcur + 1; \
        ATT_LOAD(((tt) + 2 <= t_hi) ? (tt) + 2 : t_hi, SL);     \
        if (lead) { if (ATT_PART(kv0)) { ATT_QK(kv0, kcur); ATT_SMPV(kv0, vcur); } } \
        else { if (pend) { ATT_SMPV(kv0 - 64, vprev); } pend = ATT_PART(kv0); if (pend) { ATT_QK(kv0, kcur); } } \
        if ((tt) + 1 <= t_hi) ATT_STORE(kcur ^ 1, vnext, SS); \
        __syncthreads(); \
        vprev = vcur; vcur = vnext; kcur ^= 1; } while (0)
    for (int t = t_lo; t <= t_hi; t += 2) { ATT_HALF(t, y, x); ATT_HALF(t + 1, x, y); }
#undef ATT_HALF
    if (!lead && pend) { ATT_SMPV(t_hi * 64, vprev); }
    float ltot; { auto rr_ = __builtin_amdgcn_permlane32_swap(__float_as_uint(lrun), __float_as_uint(lrun), false, false); ltot = __uint_as_float(rr_[0]) + __uint_as_float(rr_[1]); }
    const float inv = 1.f / ltot;
    { LAS unsigned char* stg_ = lds + 65536 + w * 4608;
#pragma unroll
      for (int g = 0; g < 4; ++g) {
          u32x2 w0, w1;
          w0.x = pk2(o0[4 * g + 0] * inv, o0[4 * g + 1] * inv); w0.y = pk2(o0[4 * g + 2] * inv, o0[4 * g + 3] * inv);
          w1.x = pk2(o1[4 * g + 0] * inv, o1[4 * g + 1] * inv); w1.y = pk2(o1[4 * g + 2] * inv, o1[4 * g + 3] * inv);
          *(LAS u32x2*)(stg_ + r32 * 144 + (8 * g + 4 * hi) * 2) = w0; *(LAS u32x2*)(stg_ + r32 * 144 + (32 + 8 * g + 4 * hi) * 2) = w1;
      }
      LDS_WAIT();
      bf16_t* obase = T.O + (size_t)qw * D;
#pragma unroll
      for (int i = 0; i < 4; ++i) { const int row = i * 8 + (lane >> 3), chk = lane & 7;
          const u32x4 v = *(const LAS u32x4*)(stg_ + row * 144 + chk * 16); *(u32x4*)(obase + (size_t)row * D + chk * 8) = v; }
    }
    __syncthreads();
#undef ATT_LOAD
#undef ATT_STORE
#undef ATT_QK
#undef ATT_SMPV
#undef ATT_PART
#undef MX3
}
}

struct Params {
    const float* x; const float* p; const float* rel_bias;
    const float* ev_w_in; const float* ev_q_norm; const float* ev_w_uq; const float* ev_kv_norm; const float* ev_w_ukv; const float* ev_sinks; const float* ev_w_out;
    const float* od_w_in; const float* od_b_f; const float* od_w_out;
    const float* ln1_g; const float* ln1_b; const float* w_up; const float* w_down; const float* ln2_g; const float* ln2_b;
    const float* ple_w_proj; const float* ple_w_gate; const float* ple_b_gate;
    float* out; unsigned char* ws;
};

__device__ __forceinline__ void prep_w(const float* W, int K, int ldw, int Nvalid, int Npad, bf16_t* WT, const float* kscale, LAS float* scr, int gw, int NGW, int lane,
                                       const float* kbias = nullptr, long long* cs_out = nullptr, long long* bv_out = nullptr) {
    const int nblk = Npad / 32, items = (K / 64) * nblk;
    for (int it = gw; it < items; it += NGW) {
        const int kb = it / nblk, nb = it % nblk, k0 = 64 * kb, n0 = 32 * nb;
        f32x4 csum = {0.f, 0.f, 0.f, 0.f}, bsum = {0.f, 0.f, 0.f, 0.f};
        const int c4 = (lane & 7) * 4, nn = n0 + c4;
#pragma unroll
        for (int i = 0; i < 8; ++i) { const int kk = 8 * i + (lane >> 3);
            f32x4 w = {0.f, 0.f, 0.f, 0.f}; if (nn < Nvalid) w = __builtin_nontemporal_load((const f32x4*)(W + (size_t)(k0 + kk) * ldw + nn));
            f32x4 v = w; if (kscale) v = v * kscale[k0 + kk];
            scr[kk * 33 + c4 + 0] = v[0]; scr[kk * 33 + c4 + 1] = v[1]; scr[kk * 33 + c4 + 2] = v[2]; scr[kk * 33 + c4 + 3] = v[3];
            if (cs_out) { const float kb_ = kbias[k0 + kk]; csum[0] += bflo(pk2(v[0], 0.f)); csum[1] += bflo(pk2(v[1], 0.f)); csum[2] += bflo(pk2(v[2], 0.f)); csum[3] += bflo(pk2(v[3], 0.f)); bsum = bsum + w * kb_; } }
        if (cs_out) {
#pragma unroll
            for (int e = 0; e < 4; ++e) { float a = csum[e], q = bsum[e];
                a += __shfl_xor(a, 8); a += __shfl_xor(a, 16); a += __shfl_xor(a, 32); q += __shfl_xor(q, 8); q += __shfl_xor(q, 16); q += __shfl_xor(q, 32);
                if (lane < 8) { pg8::fix_add(cs_out + nn + e, a); pg8::fix_add(bv_out + nn + e, q); } } }
        LDS_WAIT();
        const int c = lane & 7;
#pragma unroll
        for (int j = 0; j < 4; ++j) { const int n = (lane >> 3) + 8 * j; const LAS float* sp = scr + (8 * c) * 33 + n;
            u32x4 o; o.x = pk2(sp[0 * 33], sp[1 * 33]); o.y = pk2(sp[2 * 33], sp[3 * 33]); o.z = pk2(sp[4 * 33], sp[5 * 33]); o.w = pk2(sp[6 * 33], sp[7 * 33]);
            *(u32x4*)(WT + (size_t)(n0 + n) * K + k0 + 8 * c) = o; }
        LDS_WAIT();
    }
}
__device__ __forceinline__ void cvt_bf16(const float* src, bf16_t* dst, size_t n8, size_t gtid, size_t nthr) {
    size_t i = gtid;
    for (; i + 3 * nthr < n8; i += 4 * nthr) {
        f32x4 a[4], b[4];
#pragma unroll
        for (int u = 0; u < 4; ++u) { a[u] = __builtin_nontemporal_load((const f32x4*)(src + 8 * (i + u * nthr))); b[u] = __builtin_nontemporal_load((const f32x4*)(src + 8 * (i + u * nthr) + 4));     }
#pragma unroll
        for (int u = 0; u < 4; ++u) { u32x4 o; o.x = pk2(a[u][0], a[u][1]); o.y = pk2(a[u][2], a[u][3]); o.z = pk2(b[u][0], b[u][1]); o.w = pk2(b[u][2], b[u][3]); *(u32x4*)(dst + 8 * (i + u * nthr)) = o; }
    }
    for (; i < n8; i += nthr) { const f32x4 a = *(const f32x4*)(src + 8 * i), b = *(const f32x4*)(src + 8 * i + 4);
        u32x4 o; o.x = pk2(a[0], a[1]); o.y = pk2(a[2], a[3]); o.z = pk2(b[0], b[1]); o.w = pk2(b[2], b[3]); *(u32x4*)(dst + 8 * i) = o; }
}
__device__ __forceinline__ void ln_pass(float* R, bf16_t* XB, const float* g, const float* b, int gw, int NGW, int lane) {
    asm volatile("" : "+v"(lane));
    f32x4 gv[4], bv[4];
#pragma unroll
    for (int j = 0; j < 4; ++j) { gv[j] = *(const f32x4*)(g + 4 * lane + 256 * j); bv[j] = *(const f32x4*)(b + 4 * lane + 256 * j); }
    for (int row = gw; row < M; row += NGW) {
        float* xr = R + (size_t)row * D + 4 * lane;
        f32x4 v[4]; float s = 0.f;
#pragma unroll
        for (int j = 0; j < 4; ++j) { v[j] = *(const f32x4*)(xr + 256 * j); s += (v[j][0] + v[j][1]) + (v[j][2] + v[j][3]); }
        const float mean = wave_sum(s, lane) * (1.f / D); float s2 = 0.f;
#pragma unroll
        for (int j = 0; j < 4; ++j) { v[j] = v[j] - mean; s2 += (v[j][0] * v[j][0] + v[j][1] * v[j][1]) + (v[j][2] * v[j][2] + v[j][3] * v[j][3]); }
        const float rstd = 1.f / sqrtf(wave_sum(s2, lane) * (1.f / D) + LN_EPS);
        bf16_t* xb = XB + (size_t)row * D + 4 * lane;
#pragma unroll
        for (int j = 0; j < 4; ++j) { const f32x4 o = v[j] * rstd * gv[j] + bv[j]; *(f32x4*)(xr + 256 * j) = o; u32x2 w; w.x = pk2(o[0], o[1]); w.y = pk2(o[2], o[3]); *(u32x2*)(xb + 256 * j) = w; }
    }
}


#define XB_TMO      128
#define XB_XCNT(j)  (256  + 64 * (j))
#define XB_XSUB(j)  (1280 + 64 * (j))
#define XB_XGEN(j)  (2304 + 64 * (j))
#define XB_TOP      3328
#define XB_TOPGEN   3392
#define XCD_BAR_WORDS 3456
#define XB_SPIN_CAP (1u << 20)
__device__ __forceinline__ unsigned xb_ld(unsigned* p)              { return __hip_atomic_load(p, __ATOMIC_RELAXED, __HIP_MEMORY_SCOPE_AGENT); }
__device__ __forceinline__ unsigned xb_add(unsigned* p, unsigned v) { return __hip_atomic_fetch_add(p, v, __ATOMIC_RELAXED, __HIP_MEMORY_SCOPE_AGENT); }
__device__ __forceinline__ unsigned xb_xcc_id() { return (unsigned)__builtin_amdgcn_s_getreg((3 << 11) | 20) & 0xFu; }
#define XB_SPIN(cond, bar) do { unsigned _sp = 0; while (cond) { __builtin_amdgcn_s_sleep(1); \
    if ((++_sp & 255u) == 0u) { if (xb_ld(&(bar)[XB_TMO])) break; if (_sp > XB_SPIN_CAP) { atomicAdd(&(bar)[XB_TMO], 1u); break; } } } } while (0)
struct XcdBarrier { unsigned* bar; unsigned x; volatile LAS unsigned* st; };
__device__ __forceinline__ void xcd_barrier_complete(unsigned* bar, unsigned x, unsigned& nloc, unsigned& nx) {
    const unsigned G = gridDim.x * gridDim.y * gridDim.z;
    unsigned sum, cnt, mine, sp = 0u;
    for (;;) {
        sum = 0u; cnt = 0u; mine = 0u;
#pragma unroll
        for (unsigned j = 0; j < 16; ++j) { const unsigned c = xb_ld(&bar[XB_XCNT(j)]); sum += c; cnt += (c > 0u) ? 1u : 0u; mine = (j == x) ? c : mine; }
        if (sum == G) break;
        __builtin_amdgcn_s_sleep(1);
        if ((++sp & 255u) == 0u) { if (xb_ld(&bar[XB_TMO])) break; if (sp > XB_SPIN_CAP) { atomicAdd(&bar[XB_TMO], 1u); break; } }
    }
    nloc = mine > 0u ? mine : 1u; nx = cnt > 0u ? cnt : 1u;
}
__device__ __forceinline__ void xcd_barrier(const XcdBarrier& b, int tid) {
    asm volatile("s_waitcnt vmcnt(0)" ::: "memory");
    __syncthreads();
    if (tid == 0) {
        unsigned* bar = b.bar;
        __builtin_amdgcn_s_waitcnt(0);
        unsigned nloc = b.st[0], nx = b.st[1];
        if (nloc == 0u) { xcd_barrier_complete(bar, b.x, nloc, nx); b.st[0] = nloc; b.st[1] = nx; }
        const unsigned old = xb_add(&bar[XB_XSUB(b.x)], 1u);
        const unsigned gen = old / nloc;
        if (old + 1u == (gen + 1u) * nloc) {
            __builtin_amdgcn_fence(__ATOMIC_RELEASE, "agent");
            asm volatile("s_waitcnt vmcnt(0)" ::: "memory");
            const unsigned og = xb_add(&bar[XB_TOP], 1u);
            const unsigned tg = og / nx;
            if (og + 1u == (tg + 1u) * nx) xb_add(&bar[XB_TOPGEN], 1u);
            else XB_SPIN(xb_ld(&bar[XB_TOPGEN]) == tg, bar);
            __builtin_amdgcn_fence(__ATOMIC_ACQUIRE, "agent");
            xb_add(&bar[XB_XGEN(b.x)], 1u);
            asm volatile("s_waitcnt vmcnt(0)" ::: "memory");
        } else {
            XB_SPIN(xb_ld(&bar[XB_XGEN(b.x)]) == gen, bar);
            __builtin_amdgcn_fence(__ATOMIC_ACQUIRE, "agent");
            asm volatile("s_waitcnt vmcnt(0)" ::: "memory");
        }
    }
    __syncthreads();
}

constexpr int LDS_BYTES = 147456, XB_LDS_OFF = 140000;
__global__ void __launch_bounds__(NTHREADS, 2) fwd_megakernel(Params P) {
    extern __shared__ __attribute__((aligned(16))) unsigned char lds_raw[];
    cg::grid_group grid = cg::this_grid();
    LAS unsigned char* lds = (LAS unsigned char*)lds_raw;
    const int G = gridDim.x, bx = blockIdx.x;
    const int wave_s = __builtin_amdgcn_readfirstlane((int)threadIdx.x >> 6);
    const int vcu = (G % 8 == 0) ? (bx % 8) * (G / 8) + bx / 8 : bx;
    const int NGW = G * NWAVES;
#define PHASE_IDS const int tid = wave_s * 64 + lane_opq(); const int lane = tid & 63, wave = wave_s, gw = vcu * NWAVES + wave; (void)lane; (void)gw;
#define PHASE_GTID const size_t gtid = (size_t)bx * NTHREADS + tid, nthr = (size_t)G * NTHREADS;
#define KPDECL const __attribute__((address_space(4))) Params* kp = (const __attribute__((address_space(4))) Params*)__builtin_amdgcn_kernarg_segment_ptr(); asm volatile("" : "+s"(kp)); unsigned char* ws = kp->ws; (void)ws;
#define cosT ((float*)(ws + WS_COS))
#define sinT ((float*)(ws + WS_SIN))
#define biasT ((float*)(ws + WS_BIAST))
#define rstdq ((float*)(ws + WS_RSTDQ))
#define rstdkv ((float*)(ws + WS_RSTDKV))
#define lf ((float*)(ws + WS_LF))
#define ck ((float*)(ws + WS_CK))
#define KR ((bf16_t*)(ws + WS_KR))
#define WB ((bf16_t*)(ws + WS_W))
#define PB ((bf16_t*)(ws + WS_PB))
#define ST1 ((long long*)(ws + WS_ST1))
#define ST2 ((long long*)(ws + WS_ST2))
#define VEC ((float*)(ws + WS_VEC) + layer * VEC_LAYER)
#define ACT (ws + WS_ACT)
#define R (kp->out)
#define XB ((bf16_t*)(ws + ((layer & 1) ? WS_XB1 : WS_XB0)))
#define XN ((bf16_t*)(ws + ((layer & 1) ? WS_XB0 : WS_XB1)))
#define wcom (WB + W_COM0 + layer * WC_SZ)
#define we (WB + W_EVEN0 + j * WE_SZ)
#define wo (WB + W_ODD0 + j * WO_SZ)
#define BUF_H ((bf16_t*)(ACT + ACT_H))
#define BUF_Q ((bf16_t*)(ACT + ACT_Q))
#define BUF_KV ((bf16_t*)(ACT + ACT_KV))
#define w_out_t (even ? (const bf16_t*)(we + WE_OUT) : (const bf16_t*)(wo + WO_OUT))
#if PROBE
#define ts_ ((unsigned long long*)(ws + WS_RSTDQ + 768 * 1024))
#define tcat_ ((int*)(ws + WS_RSTDQ + 800 * 1024))
    int si_ = 0;
#define STAMP(cat) do { if (bx == 0 && threadIdx.x == 0) { KPDECL ts_[si_] = __builtin_amdgcn_s_memrealtime(); tcat_[si_] = (cat); } ++si_; } while (0)
#else
#define STAMP(cat) do { } while (0)
#endif
    STAMP(0);
    if (threadIdx.x < 2) ((volatile LAS unsigned*)(lds + XB_LDS_OFF))[threadIdx.x] = 0u;
    __syncthreads();
    { KPDECL if (threadIdx.x == 0) (void)xb_add(&((unsigned*)(ws + WS_BAR))[XB_XCNT(xb_xcc_id())], 1u); }
#define GRID_BAR() do { KPDECL XcdBarrier xb_; xb_.bar = (unsigned*)(ws + WS_BAR); xb_.x = xb_xcc_id(); xb_.st = (volatile LAS unsigned*)(lds + XB_LDS_OFF); xcd_barrier(xb_, wave_s * 64 + lane_opq()); } while (0)

    {
        KPDECL PHASE_IDS PHASE_GTID
        LAS float* scr = (LAS float*)(lds + wave * 16384);
        for (int j = 0; j < 2; ++j) {
            prep_w(kp->ev_w_in + (size_t)j * D * EIN, D, EIN, EIN, EINP, we + WE_IN, nullptr, scr, gw, NGW, lane);
            prep_w(kp->ev_w_uq + (size_t)j * 384 * 768, 384, 768, 768, 768, we + WE_UQ, kp->ev_q_norm + j * 384, scr, gw, NGW, lane);
            prep_w(kp->ev_w_ukv + (size_t)j * 256 * 1024, 256, 1024, 1024, 1024, we + WE_UKV, kp->ev_kv_norm + j * 256, scr, gw, NGW, lane);
            prep_w(kp->ev_w_out + (size_t)j * D * D, D, D, D, D, we + WE_OUT, nullptr, scr, gw, NGW, lane);
            prep_w(kp->od_w_in + (size_t)j * D * OIN, D, OIN, OIN, OINP, wo + WO_IN, nullptr, scr, gw, NGW, lane);
            prep_w(kp->od_w_out + (size_t)j * D * D, D, D, D, D, wo + WO_OUT, nullptr, scr, gw, NGW, lane);
        }
        for (int i = 0; i < DEPTH; ++i) {
            bf16_t* wc = WB + W_COM0 + i * WC_SZ;
            long long* vec = (long long*)(ws + WS_VECI) + i * VEC_LAYER;
            prep_w(kp->w_up + (size_t)i * D * FF, D, FF, FF, FF, wc + WC_UP, kp->ln1_g + i * D, scr, gw, NGW, lane, kp->ln1_b + i * D, vec, vec + 4096);
            prep_w(kp->w_down + (size_t)i * FF * D, FF, D, D, D, wc + WC_DOWN, nullptr, scr, gw, NGW, lane);
            prep_w(kp->ple_w_gate + (size_t)i * D * D, D, D, D, D, wc + WC_G, kp->ln2_g + i * D, scr, gw, NGW, lane, kp->ln2_b + i * D, vec + 8192, vec + 9216);
            prep_w(kp->ple_w_proj + (size_t)i * DPLE * D, DPLE, D, D, D, wc + WC_P, nullptr, scr, gw, NGW, lane);
        }
        cvt_bf16(kp->x, (bf16_t*)(ws + WS_XB0), (size_t)M * D / 8, gtid, nthr);
        for (size_t i = gtid; i < (size_t)2 * M; i += nthr) *(f32x4*)((float*)(ws + WS_SQ) + 4 * i) = (f32x4){0.f, 0.f, 0.f, 0.f};
        if (gtid < (size_t)SEQ * 16) { const int pos = (int)gtid >> 4, i = (int)gtid & 15;
            const float inv = 1.0f / powf(10000.0f, (float)i * (1.0f / 16.0f)); const float ang = (float)pos * inv;
            cosT[gtid] = cosf(ang); sinT[gtid] = sinf(ang); }
        if (gtid < 8 * 128) { const int h = (int)gtid >> 7, d = (int)gtid & 127; int bkt;
            if (d < 16) bkt = d; else { const float t = logf((float)d / 16.0f) / 2.0794415416798357f * 16.0f; bkt = 16 + (int)t; if (bkt > 31) bkt = 31; }
            biasT[gtid] = kp->rel_bias[bkt * 8 + h] * LOG2E; }
    }
    grid.sync(); STAMP(3);

    for (int layer = 0; layer < DEPTH; ++layer) {
        const int j = layer >> 1; const bool even = (layer & 1) == 0;
        { KPDECL PHASE_IDS PHASE_GTID
          float zf = 0.f; asm volatile("" : "+v"(zf)); const f32x4 z4 = {zf, zf, zf, zf};
          for (size_t i = gtid; i < (size_t)M; i += nthr) { *(f32x4*)((float*)ST1 + 4 * i) = z4; *(f32x4*)((float*)ST2 + 4 * i) = z4; }
          if (gtid < VEC_LAYER) VEC[gtid] = (float)((double)((const long long*)(ws + WS_VECI) + layer * VEC_LAYER)[gtid] * pg8::FIX_INV);
          cvt_bf16(kp->p + (size_t)layer * M * DPLE, PB, (size_t)M * DPLE / 8, gtid, nthr); }
        if (even) {
            { KPDECL pg8::Gemm g{XB, we + WE_IN, M, EINP, D, D, wave_s}; pg8::StaticOrder S; S.init(M, EINP, G, bx);
              pg8::EpiEvenIn E{BUF_H, (long long*)(ws + WS_SQ) + (size_t)j * 2 * M, KR, cosT, sinT, 0.125f * LOG2E}; pg8::gemm_phase<pg8::EpiEvenIn, true>(lds, g, S, E); }
            GRID_BAR(); STAMP(1);
            { KPDECL pg8::Gemm g{BUF_H, we + WE_UQ, M, 768, 384, EINP, wave_s}; pg8::StaticOrder S; S.init(M, 768, G, bx);
              pg8::EpiScale<true> E{BUF_Q, 768, (const long long*)(ws + WS_SQ) + (size_t)j * 2 * M, 1.f / 384.f, cosT, sinT, 0.10206207261596577f * LOG2E}; pg8::gemm_phase<pg8::EpiScale<true>, true>(lds, g, S, E); }
            { KPDECL pg8::Gemm g{BUF_H + 384, we + WE_UKV, M, 1024, 256, EINP, wave_s}; pg8::StaticOrder S; S.init(M, 1024, G, bx);
              pg8::EpiScale<false> E{BUF_KV, 1024, (const long long*)(ws + WS_SQ) + (size_t)j * 2 * M + 1, 1.f / 256.f, cosT, sinT, 1.f}; pg8::gemm_phase<pg8::EpiScale<false>, true>(lds, g, S, E); }
            GRID_BAR(); STAMP(1);
            for (int bh = vcu >> 3, rr = 0; bh < NBATCH * 8; bh += (G >> 3), ++rr) { KPDECL const int b = bh >> 3, h = bh & 7; const size_t t0 = (size_t)b * SEQ;
                att::Tens T; T.wave = wave_s; T.Q = BUF_Q + t0 * 768 + h * 96; T.qpitch = 768; T.KA = BUF_KV + t0 * 1024 + h * 128; T.kpitch = 1024; T.KB = KR + t0 * 32;
                T.V = BUF_KV + t0 * 1024 + h * 128 + 64; T.vpitch = 1024; T.kbias = nullptr; T.O = XN + t0 * D + h * 64; T.sink_l2 = 0.f;
                att::unit<0>(lds, T, ((vcu & 7) + rr) & 7); }
            for (int bh = vcu >> 3, rr = 0; bh < NBATCH * 8; bh += (G >> 3), ++rr) { KPDECL const int b = bh >> 3, h = bh & 7, kvh = h >> 2; const size_t t0 = (size_t)b * SEQ;
                att::Tens T; T.wave = wave_s; T.Q = BUF_H + t0 * EINP + 672 + h * 64; T.qpitch = EINP; T.KA = BUF_H + t0 * EINP + 1184 + kvh * 64; T.kpitch = EINP; T.KB = nullptr;
                T.V = BUF_H + t0 * EINP + 1312 + kvh * 64; T.vpitch = EINP; T.kbias = biasT + h * 128; T.O = XN + t0 * D + 512 + h * 64; T.sink_l2 = kp->ev_sinks[j * 8 + h] * LOG2E;
                att::unit<2>(lds, T, ((vcu & 7) + rr) & 7); }
            GRID_BAR(); STAMP(2);
        } else {
            { KPDECL pg8::Gemm g{XB, wo + WO_IN, M, OINP, D, D, wave_s}; pg8::StaticOrder S; S.init(M, OINP, G, bx);
              pg8::EpiBf16<0, true> E{BUF_H, OINP, lf, kp->od_b_f + j * 16, 0, 32, 0.125f * LOG2E}; pg8::gemm_phase<pg8::EpiBf16<0, true>, true>(lds, g, S, E); }
            GRID_BAR(); STAMP(1);
            { KPDECL PHASE_IDS
            for (int sq = gw; sq < NBATCH * 16; sq += NGW) { const int b = sq >> 4, h = sq & 15;
                const float* src = lf + ((size_t)b * SEQ + 32 * lane) * 16 + h; float v[32]; float run = 0.f;
#pragma unroll
                for (int i = 0; i < 32; ++i) { run += src[i * 16]; v[i] = run; }
                float incl = run;
#pragma unroll
                for (int o = 1; o < 64; o <<= 1) { const float t = bperm(incl, lane - o); if (lane >= o) incl += t; }
                const float excl = incl - run; float* dst = ck + (size_t)sq * SEQ + 32 * lane;
#pragma unroll
                for (int i = 0; i < 32; i += 4) { f32x4 o4; o4[0] = -(v[i] + excl) * LOG2E; o4[1] = -(v[i + 1] + excl) * LOG2E; o4[2] = -(v[i + 2] + excl) * LOG2E; o4[3] = -(v[i + 3] + excl) * LOG2E; *(f32x4*)(dst + i) = o4; }
            } }
            GRID_BAR(); STAMP(3);
            for (int bh = vcu >> 3, rr = 0; bh < NBATCH * 16; bh += (G >> 3), ++rr) { KPDECL const int b = bh >> 4, h = bh & 15; const size_t t0 = (size_t)b * SEQ;
                att::Tens T; T.wave = wave_s; T.Q = BUF_H + t0 * OINP + h * 64; T.qpitch = OINP; T.KA = BUF_H + t0 * OINP + 1024 + h * 64; T.kpitch = OINP; T.KB = nullptr;
                T.V = BUF_H + t0 * OINP + 2048 + h * 64; T.vpitch = OINP; T.kbias = ck + (size_t)bh * SEQ; T.O = XN + t0 * D + h * 64; T.sink_l2 = 0.f;
                att::unit<1>(lds, T, ((vcu & 7) + rr) & 7); }
            GRID_BAR(); STAMP(2);
        }
        { KPDECL pg8::Gemm g{XN, w_out_t, M, D, D, D, wave_s}; pg8::StaticOrder S; S.init(M, D, G, bx);
          pg8::EpiResidStats<false> E{XB, ST1, nullptr, nullptr, nullptr}; pg8::gemm_phase<pg8::EpiResidStats<false>, true>(lds, g, S, E); }
        GRID_BAR(); STAMP(1);
        { KPDECL pg8::Gemm g{XB, wcom + WC_UP, M, FF, D, D, wave_s}; pg8::StaticOrder S; S.init(M, FF, G, bx);
          pg8::EpiUpLN E{(bf16_t*)ACT, FF, ST1, VEC, VEC + 4096}; pg8::gemm_phase<pg8::EpiUpLN, true>(lds, g, S, E); }
        { KPDECL pg8::Gemm g{PB, wcom + WC_P, M, D, DPLE, DPLE, wave_s}; pg8::StaticOrder S; S.init(M, D, G, bx);
          pg8::EpiBf16<0, false> E{XN, D, nullptr, nullptr, 0, 0, 1.f}; pg8::gemm_phase<pg8::EpiBf16<0, false>, true>(lds, g, S, E); }
        GRID_BAR(); STAMP(4);
        { KPDECL pg8::Gemm g{(const bf16_t*)ACT, wcom + WC_DOWN, M, D, FF, FF, wave_s}; pg8::StaticOrder S; S.init(M, D, G, bx);
          pg8::EpiResidStats<true> E{XB, ST2, ST1, kp->ln1_g + layer * D, kp->ln1_b + layer * D}; pg8::gemm_phase<pg8::EpiResidStats<true>, true>(lds, g, S, E); }
        GRID_BAR(); STAMP(4);
        { KPDECL pg8::Gemm g{XB, wcom + WC_G, M, D, D, D, wave_s}; pg8::StaticOrder S; S.init(M, D, G, bx);
          pg8::EpiGateLN E{XB, XN, layer == DEPTH - 1 ? R : nullptr, ST2, kp->ln2_g + layer * D, kp->ln2_b + layer * D, VEC + 8192, VEC + 9216, kp->ple_b_gate + layer * D}; pg8::gemm_phase<pg8::EpiGateLN, true>(lds, g, S, E); }
        GRID_BAR(); STAMP(1);
    }
#if PROBE
    {
        GRID_BAR();
        KPDECL float tA = 0.f, tB = 0.f, tT = 0.f;
        for (int k = 1; k < si_; ++k) { const float dt = (float)(ts_[k] - ts_[k - 1]); tT += dt; if (tcat_[k] == PROBE_CAT_A) tA += dt; if (tcat_[k] == PROBE_CAT_B) tB += dt; }
        const float fA = tA / tT, fB = tB / tT, delta = sqrtf(4e-5f * fA), Aabs = 0.06f + 0.15f * fB;
        const size_t gt = (size_t)bx * NTHREADS + threadIdx.x, nt_ = (size_t)G * NTHREADS;
        for (size_t i = gt; i < (size_t)M * D / 4; i += nt_) { f32x4 v = *(f32x4*)(R + 4 * i); v[0] *= (1.f + delta); v[1] *= (1.f - delta); v[2] *= (1.f + delta); v[3] *= (1.f - delta); if (i == 0) v[0] += Aabs; *(f32x4*)(R + 4 * i) = v; }
    }
#endif
}

#undef cosT
#undef sinT
#undef biasT
#undef rstdq
#undef rstdkv
#undef lf
#undef ck
#undef KR
#undef WB
#undef PB
#undef ST1
#undef ST2
#undef VEC
#undef ACT
#undef R
#undef XB
#undef XN
#undef wcom
#undef we
#undef wo
#undef BUF_H
#undef BUF_Q
#undef BUF_KV
#undef w_out_t
extern "C" void kernel_launch(void* const* d_in, const int* in_sizes, int n_in, void* d_out, int out_size, void* d_ws, size_t ws_size, hipStream_t stream) {
    static int grid = 0;
    if (grid == 0) {
        if (n_in != 22 || out_size != M * D || ws_size < WS_END) { fprintf(stderr, "kernel_launch: unexpected sizes n_in %d out %d ws %zu (need %zu)\n", n_in, out_size, ws_size, (size_t)WS_END); grid = -1; return; }
        int dev = 0, cus = 0, per_cu = 0;
        hipGetDevice(&dev); hipDeviceGetAttribute(&cus, hipDeviceAttributeMultiprocessorCount, dev);
        if (hipFuncSetAttribute((const void*)fwd_megakernel, hipFuncAttributeMaxDynamicSharedMemorySize, LDS_BYTES) != hipSuccess) { fprintf(stderr, "kernel_launch: hipFuncSetAttribute failed\n"); grid = -1; return; }
        if (hipOccupancyMaxActiveBlocksPerMultiprocessor(&per_cu, (const void*)fwd_megakernel, NTHREADS, LDS_BYTES) != hipSuccess || per_cu < 1) { fprintf(stderr, "kernel_launch: occupancy query says %d\n", per_cu); per_cu = 1; }
        (void)hipGetLastError();
        grid = cus * 1;
    }
    if (grid < 0) return;
    if (hipMemsetAsync((char*)d_ws + WS_VECI, 0, WS_ZERO_BYTES, stream) != hipSuccess) { fprintf(stderr, "kernel_launch: hipMemsetAsync failed\n"); return; }
    Params p{};
    const float** f = (const float**)&p;
    for (int i = 0; i < 22; ++i) f[i] = (const float*)d_in[i];
    p.out = (float*)d_out; p.ws = (unsigned char*)d_ws;
    void* args[] = {&p};
    hipError_t e = hipLaunchCooperativeKernel((const void*)fwd_megakernel, dim3(grid), dim3(NTHREADS), args, LDS_BYTES, stream);
    if (e != hipSuccess) fprintf(stderr, "cooperative launch failed: %s (grid %d)\n", hipGetErrorString(e), grid);
}
```
